# Optimizing an MI355X kernel written in HIP

```python
import math
import jax, jax.numpy as jnp
from jax import lax
import numpy as np

D_MODEL = 1024
BATCH = 16
SEQ = 256
DEPTH = 2
DEC_BATCH = 8
DEC_SEQ = 2048
PAST_LEN = 256

GRID_W = 64
EPS = 1e-6
ROPE_BASE = 10000.0
ATTN_BLOCK = 128
RET_HEADS = 4
RET_DK = 64
RET_DV = 64
RET_CHUNK = 128
FNET_GROUPS = 4
FNET_GC = 64
MLA_HEADS = 4
MLA_Q_LORA = 256
MLA_KV_LORA = 128
MLA_NOPE = 64
MLA_ROPE = 32
MLA_V = 64
HY_CH = 256
HY_ORDER = 2
HY_BANDS = 16
HY_EMB = 1 + 2 * HY_BANDS
HY_FFN = 64
HY_FAST_DECAY = 0.3
HY_SLOW_DECAY = 1.5
HY_TARGET = 1e-2
D_FF = ((8 * D_MODEL + 3 * 256 - 1) // (3 * 256)) * 256

RET_W = RET_HEADS * RET_DV
FNET_W = FNET_GROUPS * FNET_GC
MLA_W = MLA_HEADS * MLA_V
MIX_W = RET_W + FNET_W + MLA_W + HY_CH
IN_SIZES = (RET_HEADS * RET_DK, RET_HEADS * RET_DK, RET_W, RET_W, FNET_W,
            MLA_Q_LORA, MLA_KV_LORA, MLA_ROPE, 3 * HY_CH)
IN_W = sum(IN_SIZES)
F32 = jnp.float32

kernel_name = 'hybrid_retention_fnet_mla_hyena_prefix_step'


def rmsnorm(x, g):
    xf = x.astype(F32)
    y = xf * lax.rsqrt(jnp.mean(xf * xf, axis=-1, keepdims=True) + EPS)
    return (y * g.astype(F32)).astype(x.dtype)


def grid_positions(L):
    rows = L // GRID_W
    row = jnp.repeat(jnp.arange(rows, dtype=jnp.int32), GRID_W)
    col = jnp.tile(jnp.arange(GRID_W, dtype=jnp.int32), rows)
    return row, col


def axial_rope(x):
    L, R = x.shape[1], x.shape[-1]
    half = R // 4
    row, col = grid_positions(L)
    inv = ROPE_BASE ** (-jnp.arange(half, dtype=F32) / half)

    def rot(xa, pos):
        ang = pos.astype(F32)[:, None] * inv[None, :]
        cos = jnp.cos(ang)[None, :, None, :]
        sin = jnp.sin(ang)[None, :, None, :]
        x1, x2 = jnp.split(xa.astype(F32), 2, axis=-1)
        return jnp.concatenate([x1 * cos - x2 * sin, x2 * cos + x1 * sin], axis=-1)

    xr, xc = jnp.split(x, 2, axis=-1)
    return jnp.concatenate([rot(xr, row), rot(xc, col)], axis=-1).astype(x.dtype)


def retention_scan(q, k, v, log_gamma, s0):
    B, L, H, dk = q.shape
    dv = v.shape[-1]
    C = RET_CHUNK
    n = L // C
    qc = q.reshape(B, n, C, H, dk)
    kc = k.reshape(B, n, C, H, dk)
    vc = v.reshape(B, n, C, H, dv)
    i = jnp.arange(C, dtype=F32)
    diff = i[:, None] - i[None, :]
    dmask = jnp.where(diff[None] >= 0,
                      jnp.exp(jnp.maximum(diff, 0.0)[None] * log_gamma[:, None, None]), 0.0)
    scores = jnp.einsum('bnchd,bnmhd->bnhcm', qc, kc) * dmask[None, None]
    inner = jnp.einsum('bnhcm,bnmhe->bnche', scores, vc)
    xi = jnp.exp((i[:, None] + 1.0) * log_gamma[None, :])
    zeta = jnp.exp((C - 1.0 - i)[:, None] * log_gamma[None, :])
    g_chunk = jnp.exp(C * log_gamma)
    kv = jnp.einsum('bnchd,bnche->nbhde', kc * zeta[None, None, :, :, None], vc)

    def step(S, kv_j):
        return g_chunk[None, :, None, None] * S + kv_j, S

    s_final, s_prev = lax.scan(step, s0, kv)
    cross = jnp.einsum('bnchd,nbhde->bnche', qc * xi[None, None, :, :, None], s_prev)
    return (inner + cross).reshape(B, L, H, dv), s_final


def retention(rq, rk, rv, rg, decay, s0, latent):
    B, L, _ = rq.shape
    q = rq.reshape(B, L, RET_HEADS, RET_DK)
    k = rk.reshape(B, L, RET_HEADS, RET_DK) * (RET_DK ** -0.5)
    v = rv.reshape(B, L, RET_HEADS, RET_DV)
    if latent:
        q = axial_rope(q)
        k = axial_rope(k)
    q, k, v = q.astype(F32), k.astype(F32), v.astype(F32)
    log_g = jax.nn.log_sigmoid(decay.astype(F32))
    s0 = s0.astype(F32)
    o_f, s_f = retention_scan(q, k, v, log_g[0], s0[:, 0])
    o_b, s_b = retention_scan(q[:, ::-1], k[:, ::-1], v[:, ::-1], log_g[1], s0[:, 1])
    o = o_f + o_b[:, ::-1]
    mu = jnp.mean(o, axis=-1, keepdims=True)
    var = jnp.mean(jnp.square(o - mu), axis=-1, keepdims=True)
    o = ((o - mu) * lax.rsqrt(var + EPS)).reshape(B, L, RET_W)
    out = jax.nn.silu(rg.astype(F32)) * o
    return out.astype(rq.dtype), jnp.stack([s_f, s_b], axis=1)


def fourier_mix(f):
    B, L, _ = f.shape
    ff = f.astype(F32).reshape(B, L, FNET_GROUPS, FNET_GC)
    y = jnp.fft.fftn(ff, axes=(1, 3), norm='ortho').real
    return y.reshape(B, L, FNET_W).astype(f.dtype)


def mla_keys(ckv, kr, w_ukv):
    B, L, _ = ckv.shape
    kv = (ckv @ w_ukv).reshape(B, L, MLA_HEADS, MLA_NOPE + MLA_V)
    k_nope, v = jnp.split(kv, [MLA_NOPE], axis=-1)
    k = jnp.concatenate([k_nope, jnp.broadcast_to(kr, (B, L, MLA_HEADS, MLA_ROPE)).astype(k_nope.dtype)], axis=-1)
    return k, v


def block_attention(q, k, v):
    B, Lq, H, Dh = q.shape
    nb = Lq // ATTN_BLOCK
    scale = Dh ** -0.5
    qb = jnp.moveaxis(q.reshape(B, nb, ATTN_BLOCK, H, Dh), 1, 0)

    def one(qi):
        s = jnp.einsum('bqhd,bkhd->bhqk', qi, k, preferred_element_type=F32) * scale
        pr = jax.nn.softmax(s, axis=-1)
        return jnp.einsum('bhqk,bkhe->bqhe', pr.astype(v.dtype), v)

    o = lax.map(one, qb)
    return jnp.moveaxis(o, 0, 1).reshape(B, Lq, H, v.shape[-1])


def short_conv3(u, w, b):
    up = jnp.pad(u, ((0, 0), (1, 1), (0, 0)))
    return up[:, :-2] * w[0] + up[:, 1:-1] * w[1] + up[:, 2:] * w[2] + b


def hyena_filters(L, w1, b1, w2, b2, w3):
    pos = jnp.arange(L, dtype=F32)
    t = pos / L
    bands = jnp.arange(1, HY_BANDS + 1, dtype=F32)
    ang = (2.0 * math.pi / L) * pos[:, None] * bands[None, :]
    z = jnp.concatenate([t[:, None], jnp.sin(ang), jnp.cos(ang)], axis=-1)
    h = jnp.sin(z @ w1.astype(F32) + b1.astype(F32))
    h = jnp.sin(h @ w2.astype(F32) + b2.astype(F32))
    h = (h @ w3.astype(F32)).reshape(L, HY_ORDER, 2, HY_CH)
    deltas = jnp.abs(jnp.linspace(math.log(HY_TARGET) / HY_SLOW_DECAY,
                                  math.log(HY_TARGET) / HY_FAST_DECAY, HY_CH, dtype=F32))
    window = jnp.exp(-t[:, None] * deltas[None, :])
    return h * window[:, None, None, :]


def long_conv(u, hf, hb):
    L, C = hf.shape
    g = jnp.concatenate([hf, jnp.zeros((1, C), F32), hb[1:][::-1]], axis=0)
    g = g / (jnp.sum(jnp.abs(g), axis=0, keepdims=True) + EPS)
    U = jnp.fft.rfft(u, n=2 * L, axis=1)
    G = jnp.fft.rfft(g, n=2 * L, axis=0)
    return jnp.fft.irfft(U * G[None], n=2 * L, axis=1)[:, :L]


def hyena(u, p):
    B, L, _ = u.shape
    uc = short_conv3(u, p['hy_short_w'], p['hy_short_b']).astype(F32)
    v, x1, x2 = jnp.split(uc, 3, axis=-1)
    h = hyena_filters(L, p['hy_w1'], p['hy_b1'], p['hy_w2'], p['hy_b2'], p['hy_w3'])
    d_skip = p['hy_bias'].astype(F32)
    z = v
    for o, gate in enumerate((x1, x2)):
        z = gate * (long_conv(z, h[:, o, 0], h[:, o, 1]) + d_skip[o] * z)
    return z.astype(u.dtype)


def mixer(h, p, latent, ctx_ckv, ctx_krope, s0):
    B, L, _ = h.shape
    idx = np.cumsum(IN_SIZES)[:-1].tolist()
    rq, rk, rv, rg, fu, cq, ckv, kr, hu = jnp.split(h @ p['w_in'], idx, axis=-1)
    ret_out, s_ret = retention(rq, rk, rv, rg, p['ret_decay'], s0, latent)
    four_out = fourier_mix(fu)
    cq = rmsnorm(cq, p['mla_q_norm'])
    ckv = rmsnorm(ckv, p['mla_kv_norm'])
    q = (cq @ p['mla_w_uq']).reshape(B, L, MLA_HEADS, MLA_NOPE + MLA_ROPE)
    q_nope, q_rope = jnp.split(q, [MLA_NOPE], axis=-1)
    kr_h = kr[:, :, None, :]
    kr_rot = axial_rope(kr_h) if latent else kr_h
    if latent:
        q_rope = axial_rope(q_rope)
    q = jnp.concatenate([q_nope, q_rope], axis=-1)
    k, v = mla_keys(ckv, kr_rot, p['mla_w_ukv'])
    if latent:
        k_c, v_c = mla_keys(ctx_ckv, ctx_krope[:, :, None, :], p['mla_w_ukv'])
        k = jnp.concatenate([k, k_c], axis=1)
        v = jnp.concatenate([v, v_c], axis=1)
    att = block_attention(q, k, v).reshape(B, L, MLA_W)
    hy = hyena(hu, p)
    out = jnp.concatenate([ret_out, four_out, att, hy], axis=-1) @ p['w_out']
    return out, ckv, kr, s_ret


def layer(x, mod, p, latent, ctx_ckv, ctx_krope, s0):
    sh1, sc1, g1, sh2, sc2, g2 = jnp.split(mod.astype(x.dtype), 6, axis=-1)
    norm = p['norm_g']
    h = rmsnorm(x, norm[0]) * (1.0 + sc1) + sh1
    m, ckv, kr, s_ret = mixer(h, p, latent, ctx_ckv, ctx_krope, s0)
    x = x + g1 * rmsnorm(m, norm[1])
    h = rmsnorm(x, norm[2]) * (1.0 + sc2) + sh2
    f = (jax.nn.silu(h @ p['w_gate']) * (h @ p['w_up'])) @ p['w_down']
    x = x + g2 * rmsnorm(f, norm[3])
    return x, ckv, kr, s_ret


def setup_inputs(seed: int = 0) -> dict:
    key = jax.random.key(seed)
    ks = jax.random.split(key, 28)
    nrm = lambda k, shape, s: jax.random.normal(k, shape, F32) * s
    ret_init = jnp.log(jnp.exp2(5.0 + jnp.arange(RET_HEADS, dtype=F32)) - 1.0)
    return {
        'x_prompt': nrm(ks[0], (BATCH, SEQ, D_MODEL), 1.0),
        'x_sample': nrm(ks[1], (DEC_BATCH, DEC_SEQ, D_MODEL), 1.0),
        'cache_ckv': nrm(ks[2], (DEC_BATCH, DEPTH, PAST_LEN, MLA_KV_LORA), 1.0),
        'cache_krope': nrm(ks[3], (DEC_BATCH, DEPTH, PAST_LEN, MLA_ROPE), 1.0),
        'state_ret': nrm(ks[4], (DEC_BATCH, DEPTH, 2, RET_HEADS, RET_DK, RET_DV), 0.5),
        'c': nrm(ks[5], (DEC_BATCH, D_MODEL), 1.0),
        'c_ctx': nrm(ks[6], (D_MODEL,), 1.0),
        'w_ada': nrm(ks[7], (DEPTH, D_MODEL, 6 * D_MODEL), 0.5 * D_MODEL ** -0.5),
        'b_ada': nrm(ks[8], (DEPTH, 6 * D_MODEL), 0.01),
        'norm_g': 1.0 + nrm(ks[9], (DEPTH, 4, D_MODEL), 0.01),
        'w_in': nrm(ks[10], (DEPTH, D_MODEL, IN_W), D_MODEL ** -0.5),
        'w_out': nrm(ks[11], (DEPTH, MIX_W, D_MODEL), MIX_W ** -0.5),
        'ret_decay': ret_init + nrm(ks[12], (DEPTH, 2, RET_HEADS), 0.1),
        'mla_q_norm': 1.0 + nrm(ks[13], (DEPTH, MLA_Q_LORA), 0.01),
        'mla_kv_norm': 1.0 + nrm(ks[14], (DEPTH, MLA_KV_LORA), 0.01),
        'mla_w_uq': nrm(ks[15], (DEPTH, MLA_Q_LORA, MLA_HEADS * (MLA_NOPE + MLA_ROPE)), MLA_Q_LORA ** -0.5),
        'mla_w_ukv': nrm(ks[16], (DEPTH, MLA_KV_LORA, MLA_HEADS * (MLA_NOPE + MLA_V)), MLA_KV_LORA ** -0.5),
        'hy_short_w': nrm(ks[17], (DEPTH, 3, 3 * HY_CH), 3 ** -0.5),
        'hy_short_b': nrm(ks[18], (DEPTH, 3 * HY_CH), 0.01),
        'hy_w1': nrm(ks[19], (DEPTH, HY_EMB, HY_FFN), HY_EMB ** -0.5),
        'hy_b1': nrm(ks[20], (DEPTH, HY_FFN), 0.1),
        'hy_w2': nrm(ks[21], (DEPTH, HY_FFN, HY_FFN), HY_FFN ** -0.5),
        'hy_b2': nrm(ks[22], (DEPTH, HY_FFN), 0.1),
        'hy_w3': nrm(ks[23], (DEPTH, HY_FFN, HY_ORDER * 2 * HY_CH), HY_FFN ** -0.5),
        'hy_bias': nrm(ks[24], (DEPTH, HY_ORDER, HY_CH), 0.1),
        'w_gate': nrm(ks[25], (DEPTH, D_MODEL, D_FF), D_MODEL ** -0.5),
        'w_up': nrm(ks[26], (DEPTH, D_MODEL, D_FF), D_MODEL ** -0.5),
        'w_down': nrm(ks[27], (DEPTH, D_FF, D_MODEL), D_FF ** -0.5),
    }


def reference(x_prompt, x_sample, cache_ckv, cache_krope, state_ret, c, c_ctx,
              w_ada, b_ada, norm_g, w_in, w_out, ret_decay, mla_q_norm, mla_kv_norm,
              mla_w_uq, mla_w_ukv, hy_short_w, hy_short_b, hy_w1, hy_b1, hy_w2, hy_b2,
              hy_w3, hy_bias, w_gate, w_up, w_down):
    xp = x_prompt
    xs = x_sample
    s_zero = jnp.zeros((xp.shape[0], 2, RET_HEADS, RET_DK, RET_DV), F32)
    silu_ctx = jax.nn.silu(c_ctx.astype(F32))
    silu_c = jax.nn.silu(c.astype(F32))
    new_ckv, new_kr, new_s = [], [], []
    for l in range(DEPTH):
        p = {
            'norm_g': norm_g[l], 'w_in': w_in[l], 'w_out': w_out[l], 'ret_decay': ret_decay[l],
            'mla_q_norm': mla_q_norm[l], 'mla_kv_norm': mla_kv_norm[l],
            'mla_w_uq': mla_w_uq[l], 'mla_w_ukv': mla_w_ukv[l],
            'hy_short_w': hy_short_w[l], 'hy_short_b': hy_short_b[l],
            'hy_w1': hy_w1[l], 'hy_b1': hy_b1[l], 'hy_w2': hy_w2[l], 'hy_b2': hy_b2[l],
            'hy_w3': hy_w3[l], 'hy_bias': hy_bias[l],
            'w_gate': w_gate[l], 'w_up': w_up[l], 'w_down': w_down[l],
        }
        wa = w_ada[l].astype(F32)
        ba = b_ada[l].astype(F32)
        mod_ctx = (silu_ctx @ wa + ba)[None, None, :]
        mod_lat = (silu_c @ wa + ba)[:, None, :]
        xp, ckv, kr, s_ret = layer(xp, mod_ctx, p, False, None, None, s_zero)
        new_ckv.append(ckv)
        new_kr.append(kr)
        new_s.append(s_ret.astype(xp.dtype))
        xs, _, _, _ = layer(xs, mod_lat, p, True, cache_ckv[:, l], cache_krope[:, l], state_ret[:, l])
    return (xp, xs, jnp.stack(new_ckv, axis=1), jnp.stack(new_kr, axis=1), jnp.stack(new_s, axis=1))
```

```cpp
#include <hip/hip_runtime.h>
#include <hip/hip_cooperative_groups.h>
#include <cstdio>
namespace cg = cooperative_groups;

#ifndef SINGLE_LAUNCH
#define SINGLE_LAUNCH 1
#endif
#ifndef PROBE_STAGE
#define PROBE_STAGE -1
#endif
#ifndef PROBE_SUB
#define PROBE_SUB -1
#endif
#ifndef PROBE_G
#define PROBE_G 0
#endif
#ifndef PROBE_ST
#define PROBE_ST -1
#endif
#ifndef PROBE_ATT
#define PROBE_ATT 0
#endif
#ifndef PROBE_SYNCS
#define PROBE_SYNCS 0
#endif

typedef unsigned short u16;
typedef __attribute__((ext_vector_type(8))) short bf16x8;
typedef __attribute__((ext_vector_type(4))) short bf16x4;
typedef __attribute__((ext_vector_type(4))) float f32x4;
#define DEVI __device__ __forceinline__

enum { IX_XP = 0, IX_XS, IX_CCKV, IX_CKR, IX_STATE, IX_C, IX_CCTX, IX_WADA, IX_BADA, IX_NORMG, IX_WIN, IX_WOUT,
       IX_DECAY, IX_QNORM, IX_KVNORM, IX_WUQ, IX_WUKV, IX_HSW, IX_HSB, IX_HW1, IX_HB1, IX_HW2, IX_HB2, IX_HW3,
       IX_HBIAS, IX_WG, IX_WU, IX_WDN, N_IN };

struct Params {
  const float* in[N_IN];
  float* out;
  char* ws;
};

constexpr int MC = 4096, MT = 20480;
constexpr float EPS = 1e-6f;
constexpr float LOG2_1E4 = 13.287712379549449f;
constexpr float LOG2E = 1.4426950408889634f;

constexpr size_t OUT_CKV = (size_t)MT * 1024;
constexpr size_t OUT_KR = OUT_CKV + (size_t)16 * 2 * 256 * 128;
constexpr size_t OUT_ST = OUT_KR + (size_t)16 * 2 * 256 * 32;

constexpr size_t al256(size_t x) { return (x + 255) & ~(size_t)255; }
constexpr size_t WS_WIN = 0;
constexpr size_t WS_WOUT = WS_WIN + (size_t)2816 * 1024 * 2;
constexpr size_t WS_WGU = WS_WOUT + (size_t)1024 * 1024 * 2;
constexpr size_t WS_WD = WS_WGU + (size_t)5632 * 1024 * 2;
constexpr size_t WS_WUQ = WS_WD + (size_t)1024 * 2816 * 2;
constexpr size_t WS_WUKV = WS_WUQ + (size_t)384 * 256 * 2;
constexpr size_t WS_WUKVP = WS_WUKV + (size_t)512 * 128 * 2;
constexpr size_t WS_TABL = WS_WUKVP + (size_t)512 * 128 * 2;
constexpr size_t WS_TABC = WS_TABL + (size_t)2048 * 4096 * 2;
constexpr size_t WS_MOD = WS_TABC + (size_t)256 * 512 * 2;
constexpr size_t WS_GRV = WS_MOD + al256((size_t)2 * 9 * 6144 * 4);
constexpr size_t GRV_PER_LAYER = 2359296;
constexpr size_t WS_CC = WS_GRV + (size_t)2 * GRV_PER_LAYER * 2;
constexpr size_t WS_HB = WS_CC + (size_t)2 * 2048 * 128 * 2;
constexpr size_t WS_Z1 = WS_HB + (size_t)MT * 1024 * 2;
constexpr size_t WS_BIG = WS_Z1 + (size_t)MT * 256 * 2;
constexpr size_t HB_MQ = 0;
constexpr size_t HB_MKNC = HB_MQ + (size_t)MT * 4 * 96 * 2;
constexpr size_t HB_MKNL = HB_MKNC + (size_t)64 * 256 * 64 * 2;
constexpr size_t HB_MVTC = HB_MKNL + (size_t)32 * 2304 * 64 * 2;
constexpr size_t HB_MVTL = HB_MVTC + (size_t)64 * 64 * 256 * 2;
constexpr size_t HB_END = HB_MVTL + (size_t)32 * 64 * 2304 * 2;
static_assert(HB_END <= (size_t)MT * 1024 * 2, "HB overflow");
constexpr size_t BG_CONCAT = 0;
constexpr size_t BG_RQ = BG_CONCAT + (size_t)MT * 1024 * 2;
constexpr size_t BG_RKC = BG_RQ + (size_t)MT * 256 * 2;
constexpr size_t BG_RKL = BG_RKC + (size_t)64 * 256 * 64 * 2;
constexpr size_t BG_RVTC = BG_RKL + (size_t)32 * 2176 * 64 * 2;
constexpr size_t BG_RVTL = BG_RVTC + (size_t)64 * 64 * 256 * 2;
constexpr size_t BG_RG = BG_RVTL + (size_t)32 * 64 * 2176 * 2;
constexpr size_t BG_XCS = BG_RG + (size_t)MT * 256 * 2;
constexpr size_t BG_CQ = BG_XCS + (size_t)MT * 512 * 2;
constexpr size_t BG_CKV = BG_CQ + (size_t)MT * 256 * 2;
constexpr size_t BG_HUT = BG_CKV + (size_t)MT * 128 * 2;
constexpr size_t BG_KRAC = BG_HUT + (size_t)MT * 768 * 2;
constexpr size_t BG_KRAL = BG_KRAC + (size_t)16 * 256 * 32 * 2;
constexpr size_t BG_END = BG_KRAL + (size_t)8 * 2304 * 32 * 2;
constexpr size_t BG_ACT = 0;
constexpr size_t BG_HF = 0;
static_assert((size_t)MT * 2816 * 2 <= BG_END, "act alias");
constexpr size_t WS_BAR = WS_BIG + BG_END;
constexpr size_t WS_PS = WS_BAR + 16384;
constexpr size_t WS_TOTAL = WS_PS + (size_t)288 * 1024 * 4;

constexpr int SMEM_BYTES = 74 * 1024;

typedef __attribute__((ext_vector_type(2))) float f32x2;
typedef __attribute__((ext_vector_type(2))) __bf16 bfx2;
DEVI unsigned pk2(float a, float b) {
  f32x2 v = {a, b};
  bfx2 r = __builtin_convertvector(v, bfx2);
  return __builtin_bit_cast(unsigned, r);
}
DEVI u16 f2bf(float f) { return (u16)(pk2(f, f) & 0xffffu); }
DEVI float bf2f(u16 h) { return __uint_as_float(((unsigned)h) << 16); }
DEVI float bfs(short h) { return __uint_as_float(((unsigned)(u16)h) << 16); }
DEVI float siluf(float x) { return x * __builtin_amdgcn_rcpf(1.f + __expf(-x)); }
DEVI float ex2(float x) { return __builtin_amdgcn_exp2f(x); }
typedef __attribute__((ext_vector_type(2))) unsigned u32x2;
typedef __attribute__((ext_vector_type(4))) unsigned u32x4;
DEVI bf16x4 pack4(float a, float b, float c, float d) {
  u32x2 r;
  r[0] = pk2(a, b); r[1] = pk2(c, d);
  return __builtin_bit_cast(bf16x4, r);
}
DEVI void glds16(const void* g, void* l) {
  __builtin_amdgcn_global_load_lds((const __attribute__((address_space(1))) unsigned*)g,
                                   (__attribute__((address_space(3))) unsigned*)l, 16, 0, 0);
}
DEVI int otid() { int t = threadIdx.x; asm volatile("" : "+v"(t)); return t; }
template <int N> DEVI void wait_vm() { asm volatile("s_waitcnt vmcnt(%0)" ::"n"(N) : "memory"); }
DEVI int row_base(int isl, int b) { return isl ? (MC + b * 2048) : (b * 256); }


#define XB_TMO      128
#define XB_XCNT(j)  (256  + 64 * (j))
#define XB_XSUB(j)  (1280 + 64 * (j))
#define XB_XGEN(j)  (2304 + 64 * (j))
#define XB_TOP      3328
#define XB_TOPGEN   3392
#define XCD_BAR_WORDS 3456
#define XB_SPIN_CAP (1u << 20)
#define LAS __attribute__((address_space(3)))
DEVI unsigned xb_ld(unsigned* p) { return __hip_atomic_load(p, __ATOMIC_RELAXED, __HIP_MEMORY_SCOPE_AGENT); }
DEVI unsigned xb_add(unsigned* p, unsigned v) { return __hip_atomic_fetch_add(p, v, __ATOMIC_RELAXED, __HIP_MEMORY_SCOPE_AGENT); }
DEVI unsigned xb_xcc_id() { return (unsigned)__builtin_amdgcn_s_getreg((3 << 11) | 20) & 0xFu; }
#define XB_SPIN(cond, bar) do { unsigned _sp = 0; while (cond) { __builtin_amdgcn_s_sleep(1); \
    if ((++_sp & 255u) == 0u) { if (xb_ld(&(bar)[XB_TMO])) break; if (_sp > XB_SPIN_CAP) { atomicAdd(&(bar)[XB_TMO], 1u); break; } } } } while (0)
struct XcdBarrier { unsigned* bar; unsigned x; volatile LAS unsigned* st; };
DEVI XcdBarrier xcd_barrier_post(unsigned* bar, volatile LAS unsigned* st) {
  XcdBarrier b; b.bar = bar; b.x = xb_xcc_id(); b.st = st;
  if (threadIdx.x == 0) (void)xb_add(&bar[XB_XCNT(b.x)], 1u);
  return b;
}
DEVI void xcd_barrier_complete(unsigned* bar, unsigned x, unsigned& nloc, unsigned& nx) {
  const unsigned G = gridDim.x * gridDim.y * gridDim.z;
  unsigned sum, cnt, mine, sp = 0u;
  for (;;) {
    sum = 0u; cnt = 0u; mine = 0u;
#pragma unroll
    for (unsigned j = 0; j < 16; ++j) { const unsigned c = xb_ld(&bar[XB_XCNT(j)]); sum += c; cnt += (c > 0u) ? 1u : 0u; mine = (j == x) ? c : mine; }
    if (sum == G) break;
    __builtin_amdgcn_s_sleep(1);
    if ((++sp & 255u) == 0u) { if (xb_ld(&bar[XB_TMO])) break; if (sp > XB_SPIN_CAP) { atomicAdd(&bar[XB_TMO], 1u); break; } }
  }
  nloc = mine > 0u ? mine : 1u; nx = cnt > 0u ? cnt : 1u;
}
DEVI void xcd_barrier(const XcdBarrier& b) {
  asm volatile("s_waitcnt vmcnt(0)" ::: "memory");
  __syncthreads();
  if (threadIdx.x == 0) {
    unsigned* bar = b.bar;
    __builtin_amdgcn_s_waitcnt(0);
    unsigned nloc = b.st[0], nx = b.st[1];
    if (nloc == 0u) { xcd_barrier_complete(bar, b.x, nloc, nx); b.st[0] = nloc; b.st[1] = nx; }
    const unsigned old = xb_add(&bar[XB_XSUB(b.x)], 1u);
    const unsigned gen = old / nloc;
    if (old + 1u == (gen + 1u) * nloc) {
      __builtin_amdgcn_fence(__ATOMIC_RELEASE, "agent");
      asm volatile("s_waitcnt vmcnt(0)" ::: "memory");
      const unsigned og = xb_add(&bar[XB_TOP], 1u);
      const unsigned tg = og / nx;
      if (og + 1u == (tg + 1u) * nx) xb_add(&bar[XB_TOPGEN], 1u);
      else XB_SPIN(xb_ld(&bar[XB_TOPGEN]) == tg, bar);
      __builtin_amdgcn_fence(__ATOMIC_ACQUIRE, "agent");
      xb_add(&bar[XB_XGEN(b.x)], 1u);
      asm volatile("s_waitcnt vmcnt(0)" ::: "memory");
    } else {
      XB_SPIN(xb_ld(&bar[XB_XGEN(b.x)]) == gen, bar);
      __builtin_amdgcn_fence(__ATOMIC_ACQUIRE, "agent");
      asm volatile("s_waitcnt vmcnt(0)" ::: "memory");
    }
  }
  __syncthreads();
}

enum { CW_WIN = 0, CW_WOUT, CW_WUQ, CW_WUKV, CW_WGU, CW_WD };

struct ConvSrc { const float* ptr; int ld; float scale; };
DEVI ConvSrc conv_src(const Params& p, int l, int which, int n) {
  ConvSrc s; s.scale = 1.f;
  switch (which) {
    case CW_WIN: {
      const float* w = p.in[IX_WIN] + (size_t)l * 1024 * 2464;
      s.ld = 2464;
      int col;
      if (n < 1024) { col = n; if (n >= 256 && n < 512) s.scale = 0.125f; }
      else if (n < 1536) col = 1024 + (((n - 1024) >> 6) & 3) * 64 + (n & 63);
      else if (n < 1792) col = 1280 + (n - 1536);
      else if (n < 2560) col = 1696 + (n - 1792);
      else if (n < 2688) col = 1536 + (n - 2560);
      else if (n < 2720) col = 1664 + (n - 2688);
      else { col = 0; s.scale = 0.f; }
      s.ptr = w + col;
      break;
    }
    case CW_WOUT: s.ptr = p.in[IX_WOUT] + (size_t)l * 1024 * 1024 + n; s.ld = 1024; break;
    case CW_WUQ: s.ptr = p.in[IX_WUQ] + (size_t)l * 256 * 384 + n; s.ld = 384; s.scale = 0.10206207261596577f * LOG2E; break;
    case CW_WUKV: s.ptr = p.in[IX_WUKV] + (size_t)l * 128 * 512 + n; s.ld = 512; break;
    case CW_WGU: {
      int tile = n >> 7, within = n & 127;
      int wcq = within >> 6, q = (within & 63) >> 4, i = within & 15;
      int ffcol = tile * 64 + wcq * 32 + (q >> 1) * 16 + i;
      const float* w = (q & 1) ? p.in[IX_WU] : p.in[IX_WG];
      s.ptr = w + (size_t)l * 1024 * 2816 + ffcol; s.ld = 2816;
      break;
    }
    default: s.ptr = p.in[IX_WDN] + (size_t)l * 2816 * 1024 + n; s.ld = 1024; break;
  }
  return s;
}

DEVI void conv_job(const Params& p, int l, int which, int tile, char* smem) {
  float* st = (float*)smem;
  float* trig = st + 64 * 65;
  int K;
  u16* dst;
  switch (which) {
    case CW_WIN: K = 1024; dst = (u16*)(p.ws + WS_WIN); break;
    case CW_WOUT: K = 1024; dst = (u16*)(p.ws + WS_WOUT); break;
    case CW_WUQ: K = 256; dst = (u16*)(p.ws + WS_WUQ); break;
    case CW_WUKV: K = 128; dst = (u16*)(p.ws + WS_WUKV); break;
    case CW_WGU: K = 1024; dst = (u16*)(p.ws + WS_WGU); break;
    default: K = 2816; dst = (u16*)(p.ws + WS_WD); break;
  }
  const int ktiles = K >> 6;
  const int nt = tile / ktiles, kt = tile % ktiles;
  const int n0 = nt * 64, k0 = kt * 64;
  const int tid = otid();
  const bool four = (which == CW_WIN) && (n0 >= 1024) && (n0 < 1536);
  __syncthreads();
  {
    const int nn = tid & 63, kq = tid >> 6;
    const ConvSrc cs = conv_src(p, l, which, n0 + nn);
    const float* sp = cs.ptr + (size_t)(k0 + kq) * cs.ld;
    float v[16];
#pragma unroll
    for (int it = 0; it < 16; ++it) v[it] = __builtin_nontemporal_load(sp + (size_t)(it * 4) * cs.ld);
#pragma unroll
    for (int it = 0; it < 16; ++it) {
      float x = v[it] * cs.scale;
      if (which == CW_WUQ) x *= p.in[IX_QNORM][l * 256 + k0 + it * 4 + kq];
      st[(it * 4 + kq) * 65 + nn] = x;
    }
  }
  if (four && tid < 64) {
    float fr = (float)tid * (1.f / 64.f);
    trig[tid] = (n0 >= 1280) ? __builtin_amdgcn_sinf(fr) : __builtin_amdgcn_cosf(fr);
  }
  __syncthreads();
#pragma unroll 1
  for (int it = 0; it < 16; ++it) {
    int idx = it * 256 + tid;
    int nn = idx >> 6, kk = idx & 63;
    float v;
    if (four) {
      float a = 0.f;
#pragma unroll 4
      for (int i = 0; i < 64; ++i) a += st[kk * 65 + i] * trig[(i * nn) & 63];
      v = a * 0.125f;
    } else {
      v = st[kk * 65 + nn];
    }
    if (which == CW_WUKV) {
      ((u16*)(p.ws + WS_WUKVP))[(size_t)(n0 + nn) * K + k0 + kk] = f2bf(v);
      v *= p.in[IX_KVNORM][l * 128 + k0 + kk];
    }
    dst[(size_t)(n0 + nn) * K + k0 + kk] = f2bf(v);
  }
}
constexpr int NCONV_A = 704 + 256 + 24 + 16;
constexpr int NCONV_B = 1408 + 704;
DEVI void conv_group_a(const Params& p, int l, int job, char* smem) {
  if (job < 704) conv_job(p, l, CW_WIN, job, smem);
  else if (job < 960) conv_job(p, l, CW_WOUT, job - 704, smem);
  else if (job < 984) conv_job(p, l, CW_WUQ, job - 960, smem);
  else conv_job(p, l, CW_WUKV, job - 984, smem);
}
DEVI void conv_group_b(const Params& p, int l, int job, char* smem) {
  if (job < 1408) conv_job(p, l, CW_WGU, job, smem);
  else conv_job(p, l, CW_WD, job - 1408, smem);
}

DEVI void table_job(const Params& p, int job) {
  const int tid = otid();
  if (job < 2048) {
    const int t = job;
    u16* row = (u16*)(p.ws + WS_TABL) + (size_t)t * 4096;
    const float sc = 0.022097086912079608f;
    for (int it = 0; it < 16; ++it) {
      int k = it * 256 + tid;
      int kk = k & 2047;
      float fr = (float)((t * kk) & 2047) * (1.f / 2048.f);
      float v = (k >= 2048) ? -__builtin_amdgcn_sinf(fr) : __builtin_amdgcn_cosf(fr);
      row[k] = f2bf(v * sc);
    }
  } else {
    const int t = job - 2048;
    u16* row = (u16*)(p.ws + WS_TABC) + (size_t)t * 512;
    for (int it = 0; it < 2; ++it) {
      int k = it * 256 + tid;
      int kk = k & 255;
      float fr = (float)((t * kk) & 255) * (1.f / 256.f);
      float v = (k >= 256) ? -__builtin_amdgcn_sinf(fr) : __builtin_amdgcn_cosf(fr);
      row[k] = f2bf(v * 0.0625f);
    }
  }
}

DEVI void mod_job(const Params& p, int job, char* smem) {
  float* sc = (float*)smem;
  float* red = sc + 9 * 1024;
  const int tid = otid();
  const int l = job / 192, n0 = (job % 192) * 32;
  __syncthreads();
  {
    float cv[36];
#pragma unroll
    for (int q = 0; q < 36; ++q) {
      const int i = tid + 256 * q;
      const int bi = i >> 10, k = i & 1023;
      cv[q] = (bi == 0) ? p.in[IX_CCTX][k] : p.in[IX_C][(bi - 1) * 1024 + k];
    }
#pragma unroll
    for (int q = 0; q < 36; ++q) sc[tid + 256 * q] = siluf(cv[q]);
  }
  __syncthreads();
  const int col = tid & 31, kg = tid >> 5;
  float acc[9];
#pragma unroll
  for (int i = 0; i < 9; ++i) acc[i] = 0.f;
  const float* w = p.in[IX_WADA] + (size_t)l * 1024 * 6144 + n0 + col + (size_t)(kg * 128) * 6144;
#pragma unroll 1
  for (int k8 = 0; k8 < 128; k8 += 32) {
    float wv[32];
#pragma unroll
    for (int e = 0; e < 32; ++e) wv[e] = __builtin_nontemporal_load(w + (size_t)(k8 + e) * 6144);
#pragma unroll
    for (int e = 0; e < 32; ++e)
#pragma unroll
      for (int i = 0; i < 9; ++i) acc[i] += sc[i * 1024 + kg * 128 + k8 + e] * wv[e];
  }
#pragma unroll
  for (int i = 0; i < 9; ++i) red[(kg * 9 + i) * 32 + col] = acc[i];
  __syncthreads();
  float* mod = (float*)(p.ws + WS_MOD);
  for (int i = tid; i < 9 * 32; i += 256) {
    int bi = i >> 5, c = i & 31;
    float v = p.in[IX_BADA][l * 6144 + n0 + c];
#pragma unroll
    for (int g = 0; g < 8; ++g) v += red[(g * 9 + bi) * 32 + c];
    mod[((size_t)l * 9 + bi) * 6144 + n0 + c] = v;
  }
}

DEVI void hymlp_job(const Params& p, int job, char* smem) {
  float* z = (float*)smem;
  float* h1 = z + 16 * 34;
  float* h2 = h1 + 16 * 64;
  const int tid = otid();
  const int l = job / 144, rj = job % 144;
  const int cfg = rj < 128 ? 1 : 0;
  const int pos0 = cfg ? rj * 16 : (rj - 128) * 16;
  const int L = cfg ? 2048 : 256;
  const int r0 = cfg ? pos0 : 2048 + pos0;
  __syncthreads();
  for (int i = tid; i < 16 * 33; i += 256) {
    const int pi = i / 33, q = i % 33;
    const int pos = pos0 + pi;
    float v;
    if (q == 0) v = (float)pos / (float)L;
    else {
      int band = (q <= 16) ? q : q - 16;
      float fr = (float)((pos * band) & (L - 1)) / (float)L;
      v = (q <= 16) ? __builtin_amdgcn_sinf(fr) : __builtin_amdgcn_cosf(fr);
    }
    z[pi * 34 + q] = v;
  }
  __syncthreads();
  {
    const int j = tid & 63, pg = tid >> 6;
    float a[4];
#pragma unroll
    for (int e = 0; e < 4; ++e) a[e] = p.in[IX_HB1][l * 64 + j];
    const float* w = p.in[IX_HW1] + (size_t)l * 33 * 64 + j;
    float wv1[33];
#pragma unroll
    for (int i = 0; i < 33; ++i) wv1[i] = w[i * 64];
#pragma unroll
    for (int i = 0; i < 33; ++i) {
#pragma unroll
      for (int e = 0; e < 4; ++e) a[e] += z[(pg * 4 + e) * 34 + i] * wv1[i];
    }
#pragma unroll
    for (int e = 0; e < 4; ++e) h1[(pg * 4 + e) * 64 + j] = __sinf(a[e]);
  }
  __syncthreads();
  {
    const int j = tid & 63, pg = tid >> 6;
    float a[4];
#pragma unroll
    for (int e = 0; e < 4; ++e) a[e] = p.in[IX_HB2][l * 64 + j];
    const float* w = p.in[IX_HW2] + (size_t)l * 64 * 64 + j;
#pragma unroll 1
    for (int i0 = 0; i0 < 64; i0 += 32) {
      float wv2[32];
#pragma unroll
      for (int i = 0; i < 32; ++i) wv2[i] = w[(i0 + i) * 64];
#pragma unroll
      for (int i = 0; i < 32; ++i) {
#pragma unroll
        for (int e = 0; e < 4; ++e) a[e] += h1[(pg * 4 + e) * 64 + i0 + i] * wv2[i];
      }
    }
#pragma unroll
    for (int e = 0; e < 4; ++e) h2[j * 16 + pg * 4 + e] = __sinf(a[e]);
  }
  __syncthreads();
  float* hf = (float*)(p.ws + WS_BIG + BG_HF) + ((size_t)l * 2304 + r0) * 1024;
  const float* w3 = p.in[IX_HW3] + (size_t)l * 64 * 1024;
#pragma unroll 1
  for (int q = 0; q < 4; ++q) {
    const int n = q * 256 + tid;
    float acc[16];
#pragma unroll
    for (int e = 0; e < 16; ++e) acc[e] = 0.f;
#pragma unroll 1
    for (int i0 = 0; i0 < 64; i0 += 32) {
      float wv[32];
#pragma unroll
      for (int e = 0; e < 32; ++e) wv[e] = w3[(i0 + e) * 1024 + n];
#pragma unroll
      for (int e = 0; e < 32; ++e) {
        const f32x4* hp = (const f32x4*)(h2 + (i0 + e) * 16);
#pragma unroll
        for (int g = 0; g < 4; ++g) {
          f32x4 hv = hp[g];
          acc[g * 4 + 0] += hv[0] * wv[e]; acc[g * 4 + 1] += hv[1] * wv[e];
          acc[g * 4 + 2] += hv[2] * wv[e]; acc[g * 4 + 3] += hv[3] * wv[e];
        }
      }
    }
    const int ch = n & 255;
    const float la = -3.0701134573253944f, lb = -15.350567286626972f;
    const float delta = fabsf(la + (lb - la) * ((float)ch / 255.f));
    float asum = 0.f;
    const bool bwd = (n & 256) != 0;
#pragma unroll
    for (int e = 0; e < 16; ++e) {
      const float tt = (float)(pos0 + e) / (float)L;
      const float v = acc[e] * __expf(-tt * delta);
      hf[(size_t)e * 1024 + n] = v;
      if (!(bwd && pos0 + e == 0)) asum += fabsf(v);
    }
    ((float*)(p.ws + WS_PS))[(size_t)job * 1024 + n] = asum;
  }
}

DEVI void hyfin_job(const Params& p, int job, char* smem) {
  float* red = (float*)smem;
  const int tid = otid();
  int l, cfg, o, cc, yc;
  if (job < 256) { cfg = 1; l = job >> 7; o = (job >> 6) & 1; cc = (job >> 3) & 7; yc = job & 7; }
  else { const int j = job - 256; cfg = 0; l = j >> 4; o = (j >> 3) & 1; cc = j & 7; yc = 0; }
  const int L = cfg ? 2048 : 256;
  const int ch = tid & 31, pg = tid >> 5;
  const int c = cc * 32 + ch;
  const float* hf = (const float*)(p.ws + WS_BIG + BG_HF) + ((size_t)l * 2304 + (cfg ? 0 : 2048)) * 1024 + o * 512 + c;
  const float* ps = (const float*)(p.ws + WS_PS) + ((size_t)l * 144 + (cfg ? 0 : 128)) * 1024 + o * 512 + c;
  const int njobs = cfg ? 128 : 16;
  __syncthreads();
  float s = 0.f;
#pragma unroll 8
  for (int j = pg; j < njobs; j += 8) s += ps[(size_t)j * 1024] + ps[(size_t)j * 1024 + 256];
  red[pg * 32 + ch] = s;
  __syncthreads();
  float tot = 0.f;
#pragma unroll
  for (int i = 0; i < 8; ++i) tot += red[i * 32 + ch];
  const float sc = 1.f / (tot + EPS);
  u16* g = (u16*)(p.ws + WS_GRV) + (size_t)l * GRV_PER_LAYER + (cfg ? 0 : 2097152) + ((size_t)o * 256 + c) * (2 * L);
  const int y0 = yc * 512;
#pragma unroll 8
  for (int k = 0; k < 64; ++k) {
    const int y = y0 + pg + 8 * k;
    const int d = L - y;
    float v;
    if (d == L) v = 0.f;
    else if (d >= 0) v = hf[(size_t)d * 1024] * sc;
    else v = hf[(size_t)(-d) * 1024 + 256] * sc;
    g[y] = f2bf(v);
  }
}

DEVI void cc_job(const Params& p, int job) {
  const int i0 = (job * 256 + otid()) * 8;
  const float* src = p.in[IX_CCKV] + i0;
  int b = i0 / (2 * 256 * 128), rem = i0 % (2 * 256 * 128);
  int l = rem / (256 * 128), rr = rem % (256 * 128);
  u16* dst = (u16*)(p.ws + WS_CC) + ((size_t)l * 2048 + b * 256) * 128 + rr;
  bf16x8 v;
#pragma unroll
  for (int e = 0; e < 8; ++e) v[e] = (short)f2bf(src[e]);
  *(bf16x8*)dst = v;
}

DEVI void rowop_job(const Params& p, int l, int mode, int job) {
  const int wid = otid() >> 6, lane = otid() & 63;
  const int row0 = job * 8 + wid * 2;
  const int isl = row0 >= MC;
  const int bi = isl ? 1 + ((row0 - MC) >> 11) : 0;
  const float* mod = (const float*)(p.ws + WS_MOD);
  const bool last = (mode == 2 && l == 1);
  const int ln = (mode == 2 && !last) ? l + 1 : l;
  const int nidx = (mode == 1) ? 2 : 0;
  const int moff = (mode == 1) ? 3072 : 0;
  const float* ng1 = p.in[IX_NORMG] + (size_t)(l * 4 + (mode == 1 ? 1 : 3)) * 1024;
  const float* gate = mod + ((size_t)l * 9 + bi) * 6144 + (mode == 1 ? 2048 : 5120);
  const float* ng2 = p.in[IX_NORMG] + (size_t)(ln * 4 + nidx) * 1024;
  const float* mm = mod + ((size_t)ln * 9 + bi) * 6144 + moff;
  float4 xv[2][4], gv[4], nv1[4], nv2[4], sh[4], sc[4];
  bf16x4 mraw[2][4];
#pragma unroll
  for (int r = 0; r < 2; ++r) {
    const int row = row0 + r;
    const float* xin;
    if (mode == 2 || l > 0) xin = p.out + (size_t)row * 1024;
    else xin = isl ? p.in[IX_XS] + (size_t)(row - MC) * 1024 : p.in[IX_XP] + (size_t)row * 1024;
#pragma unroll
    for (int q = 0; q < 4; ++q) {
      const f32x4 t = __builtin_nontemporal_load((const f32x4*)(xin + q * 256 + lane * 4));
      xv[r][q] = make_float4(t[0], t[1], t[2], t[3]);
    }
    if (mode != 0) {
      const u16* hb = (const u16*)(p.ws + WS_HB) + (size_t)row * 1024;
#pragma unroll
      for (int q = 0; q < 4; ++q) mraw[r][q] = __builtin_nontemporal_load((const bf16x4*)(hb + q * 256 + lane * 4));
    }
  }
  if (mode != 0) {
#pragma unroll
    for (int q = 0; q < 4; ++q) {
      gv[q] = *(const float4*)(gate + q * 256 + lane * 4);
      nv1[q] = *(const float4*)(ng1 + q * 256 + lane * 4);
    }
  }
  if (!last) {
#pragma unroll
    for (int q = 0; q < 4; ++q) {
      nv2[q] = *(const float4*)(ng2 + q * 256 + lane * 4);
      sh[q] = *(const float4*)(mm + q * 256 + lane * 4);
      sc[q] = *(const float4*)(mm + 1024 + q * 256 + lane * 4);
    }
  }
#pragma unroll
  for (int r = 0; r < 2; ++r) {
    const int row = row0 + r;
    u16* hb = (u16*)(p.ws + WS_HB) + (size_t)row * 1024;
    float* X = p.out + (size_t)row * 1024;
    float x[16];
#pragma unroll
    for (int q = 0; q < 4; ++q) { x[q * 4 + 0] = xv[r][q].x; x[q * 4 + 1] = xv[r][q].y; x[q * 4 + 2] = xv[r][q].z; x[q * 4 + 3] = xv[r][q].w; }
    if (mode != 0) {
      float mv[16];
      float ss = 0.f;
#pragma unroll
      for (int q = 0; q < 4; ++q) {
#pragma unroll
        for (int e = 0; e < 4; ++e) { mv[q * 4 + e] = bfs(mraw[r][q][e]); ss += mv[q * 4 + e] * mv[q * 4 + e]; }
      }
#pragma unroll
      for (int s = 1; s < 64; s <<= 1) ss += __shfl_xor(ss, s);
      const float rs = rsqrtf(ss * (1.f / 1024.f) + EPS);
#pragma unroll
      for (int q = 0; q < 4; ++q) {
        x[q * 4 + 0] += gv[q].x * (mv[q * 4 + 0] * rs * nv1[q].x);
        x[q * 4 + 1] += gv[q].y * (mv[q * 4 + 1] * rs * nv1[q].y);
        x[q * 4 + 2] += gv[q].z * (mv[q * 4 + 2] * rs * nv1[q].z);
        x[q * 4 + 3] += gv[q].w * (mv[q * 4 + 3] * rs * nv1[q].w);
        __builtin_nontemporal_store((f32x4){x[q * 4 + 0], x[q * 4 + 1], x[q * 4 + 2], x[q * 4 + 3]}, (f32x4*)(X + q * 256 + lane * 4));
      }
    }
    if (!last) {
      float ss = 0.f;
#pragma unroll
      for (int e = 0; e < 16; ++e) ss += x[e] * x[e];
#pragma unroll
      for (int s = 1; s < 64; s <<= 1) ss += __shfl_xor(ss, s);
      const float rs = rsqrtf(ss * (1.f / 1024.f) + EPS);
#pragma unroll
      for (int q = 0; q < 4; ++q) {
        bf16x4 o = pack4(x[q * 4 + 0] * rs * nv2[q].x * (1.f + sc[q].x) + sh[q].x, x[q * 4 + 1] * rs * nv2[q].y * (1.f + sc[q].y) + sh[q].y,
                         x[q * 4 + 2] * rs * nv2[q].z * (1.f + sc[q].z) + sh[q].z, x[q * 4 + 3] * rs * nv2[q].w * (1.f + sc[q].w) + sh[q].w);
        *(bf16x4*)(hb + q * 256 + lane * 4) = o;
      }
    }
  }
}

DEVI void l1extra_job(const Params& p, int l, int job) {
  const int tid = otid();
  const int b = job >> 2, h = job & 3;
  u16* rk = (u16*)(p.ws + WS_BIG + BG_RKL) + ((size_t)job * 2176 + 2048) * 64;
  u16* rvt = (u16*)(p.ws + WS_BIG + BG_RVTL) + (size_t)job * 64 * 2176 + 2048;
  const float* st = p.in[IX_STATE] + (size_t)((b * 2 + l) * 2) * 4 * 4096;
  for (int i = tid; i < 128 * 64; i += 256) {
    int kk = i >> 6, d = i & 63;
    rk[i] = ((kk & 63) == d) ? (u16)0x3f80 : (u16)0;
    int e = i >> 7, vi = i & 127;
    int dir = vi >> 6, dk = vi & 63;
    rvt[(size_t)e * 2176 + vi] = f2bf(st[((size_t)(dir * 4 + h) * 64 + dk) * 64 + e]);
  }
  if (h == 0) {
    u16* kr = (u16*)(p.ws + WS_BIG + BG_KRAL) + ((size_t)b * 2304 + 2048) * 32;
    const float* src = p.in[IX_CKR] + (size_t)(b * 2 + l) * 256 * 32;
    for (int i = tid; i < 256 * 32; i += 256) kr[i] = f2bf(src[i]);
  }
}

enum { EPI_WIN = 0, EPI_MQ, EPI_MKV, EPI_MKVC, EPI_FOUR, EPI_WOUT, EPI_FFNUP, EPI_FFNDN };

template <int EPI, int MI>
DEVI void gemm_job(const Params& p, int l, const u16* __restrict__ A, int lda, const u16* __restrict__ Bt, int ldb,
                   int K, int mt, int nt, int aux, char* smem) {
  const int tid = otid(), wid = tid >> 6, lane = tid & 63;
  const int wr = wid >> 1, wc = wid & 1, fr = lane & 15, fq = lane >> 4;
  constexpr int TM = MI * 32;
  constexpr int SB = (TM + 128) * 64;
  constexpr int BOFF = TM * 64;
  constexpr int NST = (MI == 8) ? 3 : 4;
  constexpr int NLD = (MI + 1) / 2 + 2;
  const int wrow = wr * (MI * 16);
  float* sRS = (float*)(smem + 73728);
  const u16* Ab = A + (size_t)mt * TM * lda;
  const u16* Bb = Bt + (size_t)nt * 128 * ldb;
  __syncthreads();
  if (EPI == EPI_MKV && nt == 0 && mt * TM < MC)
#pragma unroll 1
  for (int rr_ = 0; rr_ < TM / 128; ++rr_) {
    const int r = rr_ * 128 + (tid >> 1), hf = tid & 1;
    const u16* rowp = Ab + (size_t)r * lda + hf * 64;
    bf16x8 v[8];
#pragma unroll
    for (int c = 0; c < 8; ++c) v[c] = *(const bf16x8*)(rowp + c * 8);
    float ss = 0.f;
#pragma unroll
    for (int c = 0; c < 8; ++c)
#pragma unroll
      for (int e = 0; e < 8; ++e) { float f = bfs(v[c][e]); ss += f * f; }
    ss += __shfl_xor(ss, 1);
    const float rs = rsqrtf(ss * (1.f / 128.f) + EPS);
    const int row = mt * TM + r;
    const int b = row >> 8, t = row & 255;
    float* o = p.out + OUT_CKV + ((size_t)(b * 2 + l) * 256 + t) * 128 + hf * 64;
    const float* g = p.in[IX_KVNORM] + l * 128 + hf * 64;
#pragma unroll
    for (int c = 0; c < 8; ++c) {
      float4 g0 = *(const float4*)(g + c * 8), g1 = *(const float4*)(g + c * 8 + 4);
      *(float4*)(o + c * 8) = make_float4(bfs(v[c][0]) * rs * g0.x, bfs(v[c][1]) * rs * g0.y, bfs(v[c][2]) * rs * g0.z, bfs(v[c][3]) * rs * g0.w);
      *(float4*)(o + c * 8 + 4) = make_float4(bfs(v[c][4]) * rs * g1.x, bfs(v[c][5]) * rs * g1.y, bfs(v[c][6]) * rs * g1.z, bfs(v[c][7]) * rs * g1.w);
    }
    asm volatile("s_waitcnt vmcnt(0)" ::: "memory");
  }
  float rss = 0.f;
  const int rsoff = (MI == 8 ? tid : (tid >> 1)) * 64;
  const int rsc0 = (MI == 8) ? 0 : (((tid & 1) * 2) ^ ((0 - (tid >> 3)) & 3)) * 16;
  const int rsc1 = (MI == 8) ? 16 : (((tid & 1) * 2 + 1) ^ ((0 - (tid >> 3)) & 3)) * 16;
  const int srow = tid >> 2;
  const int scol = ((tid & 3) ^ ((0 - (srow >> 2)) & 3)) * 8;
  const u16* ga = Ab + (size_t)srow * lda + scol;
  const u16* gb = Bb + (size_t)srow * ldb + scol;
  auto stage_a = [&](int kt, int buf) {
    char* d = smem + buf * SB + tid * 16;
#pragma unroll
    for (int i = 0; i < (MI + 1) / 2; ++i) glds16(ga + (size_t)(64 * i) * lda + kt * 32, d + i * 4096);
  };
  auto stage_b = [&](int kt, int buf) {
    char* d = smem + buf * SB + tid * 16;
#pragma unroll
    for (int i = 0; i < 2; ++i) glds16(gb + (size_t)(64 * i) * ldb + kt * 32, d + BOFF + i * 4096);
  };
  auto stage = [&](int kt, int buf) { stage_a(kt, buf); stage_b(kt, buf); };
  f32x4 acc[MI][4];
  const int nk = K >> 5;
#pragma unroll 1
  for (int rep_ = 0; rep_ < ((PROBE_G == 1 && EPI == EPI_MKV) ? 2 : 1); ++rep_) {
  if (rep_) { asm volatile("s_waitcnt vmcnt(0) lgkmcnt(0)" ::: "memory"); __syncthreads(); rss = 0.f; }
#pragma unroll
  for (int m = 0; m < MI; ++m)
#pragma unroll
    for (int n = 0; n < 4; ++n) acc[m][n] = (f32x4){0.f, 0.f, 0.f, 0.f};
  const int sw = (fq ^ ((0 - (fr >> 2)) & 3)) * 16;
  const int aoff = (wrow + fr) * 64 + sw, boff = BOFF + (wc * 64 + fr) * 64 + sw;
#pragma unroll
  for (int s = 0; s < NST - 1; ++s)
    if (s < nk) stage(s, s);
  int cb = 0, nb2 = NST - 1;
#pragma unroll 1
  for (int kt = 0; kt < nk; ++kt) {
    const int ahead = nk - 1 - kt;
    if (NST == 4) {
      if (ahead >= 2) wait_vm<2 * NLD>();
      else if (ahead == 1) wait_vm<NLD>();
      else wait_vm<0>();
    } else {
      if (ahead >= 1) wait_vm<NLD>();
      else wait_vm<0>();
    }
    __builtin_amdgcn_s_barrier();
    const bool more = kt + NST - 1 < nk;
    const char* base = smem + cb * SB;
    if (EPI == EPI_MQ || EPI == EPI_MKV) {
      bf16x8 x0 = *(const bf16x8*)(base + rsoff + rsc0), x1 = *(const bf16x8*)(base + rsoff + rsc1);
#pragma unroll
      for (int e = 0; e < 8; ++e) { float f0 = bfs(x0[e]), f1 = bfs(x1[e]); rss += f0 * f0 + f1 * f1; }
      if (MI == 8) {
        bf16x8 x2 = *(const bf16x8*)(base + rsoff + 32), x3 = *(const bf16x8*)(base + rsoff + 48);
#pragma unroll
        for (int e = 0; e < 8; ++e) { float f0 = bfs(x2[e]), f1 = bfs(x3[e]); rss += f0 * f0 + f1 * f1; }
      }
    }
    bf16x8 af[MI], bfv[4];
    constexpr int H1 = MI / 2;
#pragma unroll
    for (int m = 0; m < H1; ++m) af[m] = *(const bf16x8*)(base + aoff + m * 1024);
#pragma unroll
    for (int n = 0; n < 4; ++n) bfv[n] = *(const bf16x8*)(base + boff + n * 1024);
    __builtin_amdgcn_sched_barrier(0);
#pragma unroll
    for (int m = 0; m < H1 / 2; ++m)
#pragma unroll
      for (int n = 0; n < 4; ++n) acc[m][n] = __builtin_amdgcn_mfma_f32_16x16x32_bf16(af[m], bfv[n], acc[m][n], 0, 0, 0);
    __builtin_amdgcn_sched_barrier(0);
#pragma unroll
    for (int m = H1; m < MI; ++m) af[m] = *(const bf16x8*)(base + aoff + m * 1024);
    if (more) stage_a(kt + NST - 1, nb2);
    __builtin_amdgcn_sched_barrier(0);
#pragma unroll
    for (int m = H1 / 2; m < H1; ++m)
#pragma unroll
      for (int n = 0; n < 4; ++n) acc[m][n] = __builtin_amdgcn_mfma_f32_16x16x32_bf16(af[m], bfv[n], acc[m][n], 0, 0, 0);
    __builtin_amdgcn_sched_barrier(0);
    if (more) stage_b(kt + NST - 1, nb2);
    __builtin_amdgcn_sched_barrier(0);
#pragma unroll
    for (int m = H1; m < MI; ++m)
#pragma unroll
      for (int n = 0; n < 4; ++n) acc[m][n] = __builtin_amdgcn_mfma_f32_16x16x32_bf16(af[m], bfv[n], acc[m][n], 0, 0, 0);
    cb = (cb + 1 == NST) ? 0 : cb + 1;
    nb2 = (nb2 + 1 == NST) ? 0 : nb2 + 1;
  }
  }
  if (EPI == EPI_MQ || EPI == EPI_MKV) {
    if (MI == 8) {
      sRS[tid] = rsqrtf(rss / (float)K + EPS);
    } else {
      rss += __shfl_xor(rss, 1);
      if ((tid & 1) == 0) sRS[tid >> 1] = rsqrtf(rss / (float)K + EPS);
    }
    __syncthreads();
  }
  const int r0 = mt * TM;
#pragma unroll 1
  for (int rep2_ = 0; rep2_ < ((PROBE_G == 2 && EPI == EPI_MKV) ? 2 : 1); ++rep2_)
  if (EPI == EPI_WIN) {
    const int isl = r0 >= MC;
    const int b = isl ? (r0 - MC) >> 11 : r0 >> 8;
    const int tb = isl ? (r0 - MC) & 2047 : r0 & 255;
    const int L = isl ? 2048 : 256;
    char* big = p.ws + WS_BIG;
    if (nt < 4) {
      const int head = (nt & 1) * 2 + wc;
      const bool isk = nt >= 2;
      u16* dst;
      if (!isk) dst = (u16*)(big + BG_RQ) + (isl ? (size_t)MC * 256 + (size_t)(b * 4 + head) * 2048 * 64 : (size_t)(b * 4 + head) * 256 * 64);
      else dst = isl ? (u16*)(big + BG_RKL) + (size_t)(b * 4 + head) * 2176 * 64 : (u16*)(big + BG_RKC) + (size_t)(b * 4 + head) * 256 * 64;
      const float inv = ex2(-(float)fr * (LOG2_1E4 / 16.f));
#pragma unroll
      for (int m = 0; m < MI; ++m)
#pragma unroll
        for (int j = 0; j < 4; ++j) {
          const int t = tb + wrow + m * 16 + fq * 4 + j;
          float o0 = acc[m][0][j], o1 = acc[m][1][j], o2 = acc[m][2][j], o3 = acc[m][3][j];
          if (isl) {
            float ar = (float)(t >> 6) * inv, ac = (float)(t & 63) * inv;
            float cr = __cosf(ar), sr = __sinf(ar), cc = __cosf(ac), sc = __sinf(ac);
            float n0 = o0 * cr - o1 * sr, n1 = o1 * cr + o0 * sr, n2 = o2 * cc - o3 * sc, n3 = o3 * cc + o2 * sc;
            o0 = n0; o1 = n1; o2 = n2; o3 = n3;
          }
          u16* d = dst + (size_t)t * 64 + fr;
          d[0] = f2bf(o0); d[16] = f2bf(o1); d[32] = f2bf(o2); d[48] = f2bf(o3);
        }
    } else if (nt < 6) {
      const int head = (nt & 1) * 2 + wc;
      const int Lk = isl ? 2176 : 256;
      u16* dst = isl ? (u16*)(big + BG_RVTL) + (size_t)(b * 4 + head) * 64 * 2176 : (u16*)(big + BG_RVTC) + (size_t)(b * 4 + head) * 64 * 256;
#pragma unroll
      for (int m = 0; m < MI; ++m)
#pragma unroll
        for (int n = 0; n < 4; ++n) {
          const int t = tb + wrow + m * 16 + fq * 4;
          *(bf16x4*)(dst + (size_t)(n * 16 + fr) * Lk + t) = pack4(acc[m][n][0], acc[m][n][1], acc[m][n][2], acc[m][n][3]);
        }
    } else if (nt < 8 || nt == 12 || nt == 13 || nt == 20) {
      u16* dst;
      int ld, c0;
      if (nt < 8) { dst = (u16*)(big + BG_RG); ld = 256; c0 = (nt - 6) * 128; }
      else if (nt < 14) { dst = (u16*)(big + BG_CQ); ld = 256; c0 = (nt - 12) * 128; }
      else { dst = (u16*)(big + BG_CKV); ld = 128; c0 = 0; }
#pragma unroll
      for (int m = 0; m < MI; ++m)
#pragma unroll
        for (int n = 0; n < 4; ++n)
#pragma unroll
          for (int j = 0; j < 4; ++j) {
            float v = acc[m][n][j];
            if (nt < 8) v = siluf(v);
            dst[(size_t)(r0 + wrow + m * 16 + fq * 4 + j) * ld + c0 + wc * 64 + n * 16 + fr] = f2bf(v);
          }
    } else if (nt < 12) {
      const int half = nt >= 10;
      u16* dst = (u16*)(big + BG_XCS) + (isl ? (size_t)MC * 512 + (size_t)b * 256 * 4096 : (size_t)b * 256 * 512);
#pragma unroll
      for (int m = 0; m < MI; ++m)
#pragma unroll
        for (int n = 0; n < 4; ++n) {
          const int ch = (nt & 1) * 128 + wc * 64 + n * 16 + fr;
          const int t = tb + wrow + m * 16 + fq * 4;
          *(bf16x4*)(dst + (size_t)ch * (2 * L) + half * L + t) = pack4(acc[m][n][0], acc[m][n][1], acc[m][n][2], acc[m][n][3]);
        }
    } else if (nt < 20) {
      u16* dst = (u16*)(big + BG_HUT) + (isl ? (size_t)MC * 768 + (size_t)b * 768 * 2048 : (size_t)b * 768 * 256);
#pragma unroll
      for (int m = 0; m < MI; ++m)
#pragma unroll
        for (int n = 0; n < 4; ++n) {
          const int ch = (nt - 14) * 128 + wc * 64 + n * 16 + fr;
          const int t = tb + wrow + m * 16 + fq * 4;
          *(bf16x4*)(dst + (size_t)ch * L + t) = pack4(acc[m][n][0], acc[m][n][1], acc[m][n][2], acc[m][n][3]);
        }
    } else {
      if (wc == 0) {
        const float inv = ex2(-(float)(fr & 7) * (LOG2_1E4 / 8.f));
#pragma unroll
        for (int m = 0; m < MI; ++m)
#pragma unroll
          for (int n = 0; n < 2; ++n)
#pragma unroll
            for (int j = 0; j < 4; ++j) {
              const int t = tb + wrow + m * 16 + fq * 4 + j;
              const int d = n * 16 + fr;
              float v = acc[m][n][j];
              float pr = __shfl_xor(v, 8);
              if (!isl) {
                p.out[OUT_KR + ((size_t)(b * 2 + l) * 256 + t) * 32 + d] = v;
                ((u16*)(big + BG_KRAC))[((size_t)b * 256 + t) * 32 + d] = f2bf(v);
              } else {
                float ang = (float)(n == 0 ? (t >> 6) : (t & 63)) * inv;
                float cs = __cosf(ang), sn = __sinf(ang);
                float o = (fr & 8) ? (v * cs + pr * sn) : (v * cs - pr * sn);
                ((u16*)(big + BG_KRAL))[((size_t)b * 2304 + t) * 32 + d] = f2bf(o);
              }
            }
      }
    }
  } else if (EPI == EPI_MQ) {
    const int isl = r0 >= MC;
    const int b = isl ? (r0 - MC) >> 11 : r0 >> 8;
    const int tb = isl ? (r0 - MC) & 2047 : r0 & 255;
    const int L = isl ? 2048 : 256;
    u16* dst = (u16*)(p.ws + WS_HB + HB_MQ) + (isl ? (size_t)MC * 384 : 0);
    const float inv = ex2(-(float)(fr & 7) * (LOG2_1E4 / 8.f));
#pragma unroll
    for (int n = 0; n < 4; ++n) {
      const int c0 = nt * 128 + wc * 64 + n * 16;
      const int head = c0 / 96, d0 = c0 % 96;
#pragma unroll
      for (int m = 0; m < MI; ++m)
#pragma unroll
        for (int j = 0; j < 4; ++j) {
          const int lr = wrow + m * 16 + fq * 4 + j;
          const int t = tb + lr;
          float v = acc[m][n][j] * sRS[lr];
          if (isl && d0 >= 64) {
            float pr = __shfl_xor(v, 8);
            float ang = (float)(d0 == 64 ? (t >> 6) : (t & 63)) * inv;
            float cs = __cosf(ang), sn = __sinf(ang);
            v = (fr & 8) ? (v * cs + pr * sn) : (v * cs - pr * sn);
          }
          dst[((size_t)(b * 4 + head) * L + t) * 96 + d0 + fr] = f2bf(v);
        }
    }
  } else if (EPI == EPI_MKV || EPI == EPI_MKVC) {
    int isl, b, tk, Lk;
    if (EPI == EPI_MKV) {
      isl = r0 >= MC;
      b = isl ? (r0 - MC) >> 11 : r0 >> 8;
      tk = isl ? (r0 - MC) & 2047 : r0 & 255;
    } else {
      isl = 1; b = mt >> 1; tk = 2048 + (mt & 1) * 128;
    }
    Lk = isl ? 2304 : 256;
    const int h = nt;
    if (wc == 0) {
      u16* dst = (u16*)(p.ws + WS_HB + (isl ? HB_MKNL : HB_MKNC)) + (size_t)(b * 4 + h) * Lk * 64;
#pragma unroll
      for (int m = 0; m < MI; ++m)
#pragma unroll
        for (int n = 0; n < 4; ++n)
#pragma unroll
          for (int j = 0; j < 4; ++j) {
            const int lr = wrow + m * 16 + fq * 4 + j;
            float v = acc[m][n][j];
            if (EPI == EPI_MKV) v *= sRS[lr];
            dst[(size_t)(tk + lr) * 64 + n * 16 + fr] = f2bf(v);
          }
    } else {
      u16* dst = (u16*)(p.ws + WS_HB + (isl ? HB_MVTL : HB_MVTC)) + (size_t)(b * 4 + h) * 64 * Lk;
#pragma unroll
      for (int m = 0; m < MI; ++m)
#pragma unroll
        for (int n = 0; n < 4; ++n) {
          const int lr = wrow + m * 16 + fq * 4;
          float s0 = 1.f, s1 = 1.f, s2 = 1.f, s3 = 1.f;
          if (EPI == EPI_MKV) { s0 = sRS[lr]; s1 = sRS[lr + 1]; s2 = sRS[lr + 2]; s3 = sRS[lr + 3]; }
          *(bf16x4*)(dst + (size_t)(n * 16 + fr) * Lk + tk + lr) =
              pack4(acc[m][n][0] * s0, acc[m][n][1] * s1, acc[m][n][2] * s2, acc[m][n][3] * s3);
        }
    }
  } else if (EPI == EPI_FOUR) {
    u16* dst = (u16*)(p.ws + WS_BIG + BG_CONCAT);
#pragma unroll
    for (int m = 0; m < MI; ++m)
#pragma unroll
      for (int n = 0; n < 4; ++n)
#pragma unroll
        for (int j = 0; j < 4; ++j)
          dst[(size_t)(aux + r0 + wrow + m * 16 + fq * 4 + j) * 1024 + 256 + nt * 128 + wc * 64 + n * 16 + fr] = f2bf(acc[m][n][j]);
  } else if (EPI == EPI_WOUT || EPI == EPI_FFNDN) {
    u16* dst = (u16*)(p.ws + WS_HB);
#pragma unroll
    for (int m = 0; m < MI; ++m)
#pragma unroll
      for (int n = 0; n < 4; ++n)
#pragma unroll
        for (int j = 0; j < 4; ++j)
          dst[(size_t)(r0 + wrow + m * 16 + fq * 4 + j) * 1024 + nt * 128 + wc * 64 + n * 16 + fr] = f2bf(acc[m][n][j]);
  } else if (EPI == EPI_FFNUP) {
    u16* dst = (u16*)(p.ws + WS_BIG + BG_ACT);
#pragma unroll
    for (int m = 0; m < MI; ++m)
#pragma unroll
      for (int n = 0; n < 4; n += 2)
#pragma unroll
        for (int j = 0; j < 4; ++j) {
          float g = acc[m][n][j], u = acc[m][n + 1][j];
          dst[(size_t)(r0 + wrow + m * 16 + fq * 4 + j) * 2816 + nt * 64 + wc * 32 + (n >> 1) * 16 + fr] = f2bf(siluf(g) * u);
        }
  }
}

template <int MODE>
DEVI void attn_job(const Params& p, int l, int job, char* smem) {
  constexpr int DQK = MODE == 0 ? 96 : 64;
  constexpr int KS = DQK / 32;
  constexpr int KSTR = DQK + 8;
  constexpr int KCH = DQK / 8;
  constexpr int NKL = (64 * KCH) / 256;
  const int tid = otid(), wid = tid >> 6, lane = tid & 63, fr = lane & 15, fq = lane >> 4;
  int isl, b, h, qt;
  if (job < 512) { isl = 1; const int bhj = job & 31; b = bhj >> 2; h = bhj & 3; qt = job >> 5; }
  else { int j = job - 512; isl = 0; const int bhj = j & 63; b = bhj >> 2; h = bhj & 3; qt = j >> 6; }
  const int L = isl ? 2048 : 256;
  const int Lk = MODE == 0 ? (isl ? 2304 : 256) : (isl ? 2176 : 256);
  const int bh = b * 4 + h;
  const u16 *Q, *Kn, *Kr = nullptr, *Vt;
  if (MODE == 0) {
    Q = (const u16*)(p.ws + WS_HB + HB_MQ) + (isl ? (size_t)MC * 384 : 0) + (size_t)bh * L * 96;
    Kn = (const u16*)(p.ws + WS_HB + (isl ? HB_MKNL : HB_MKNC)) + (size_t)bh * Lk * 64;
    Kr = (const u16*)(p.ws + WS_BIG + (isl ? BG_KRAL : BG_KRAC)) + (size_t)b * Lk * 32;
    Vt = (const u16*)(p.ws + WS_HB + (isl ? HB_MVTL : HB_MVTC)) + (size_t)bh * 64 * Lk;
  } else {
    Q = (const u16*)(p.ws + WS_BIG + BG_RQ) + (isl ? (size_t)MC * 256 : 0) + (size_t)bh * L * 64;
    Kn = (const u16*)(p.ws + WS_BIG + (isl ? BG_RKL : BG_RKC)) + (size_t)bh * Lk * 64;
    Vt = (const u16*)(p.ws + WS_BIG + (isl ? BG_RVTL : BG_RVTC)) + (size_t)bh * 64 * Lk;
  }
  u16* sK = (u16*)smem;
  u16* sV = sK + 64 * KSTR;
  const int q0 = qt * 128 + wid * 32;
  bf16x8 qf[2][KS];
#pragma unroll
  for (int nb = 0; nb < 2; ++nb)
#pragma unroll
    for (int ks = 0; ks < KS; ++ks) qf[nb][ks] = *(const bf16x8*)(Q + (size_t)(q0 + nb * 16 + fr) * DQK + ks * 32 + fq * 8);
  f32x4 o[4][2];
#pragma unroll
  for (int eb = 0; eb < 4; ++eb)
#pragma unroll
    for (int nb = 0; nb < 2; ++nb) o[eb][nb] = (f32x4){0.f, 0.f, 0.f, 0.f};
  float mrun[2] = {-1e30f, -1e30f}, lsum[2] = {0.f, 0.f};
  float lgf = 0.f, lgb = 0.f;
  if (MODE == 1) {
    float df = p.in[IX_DECAY][(l * 2 + 0) * 4 + h], db = p.in[IX_DECAY][(l * 2 + 1) * 4 + h];
    lgf = -__log2f(1.f + __expf(-df));
    lgb = -__log2f(1.f + __expf(-db));
  }
  float colf[4][4], colb[4][4];
  if (MODE == 1) {
#pragma unroll
    for (int mb = 0; mb < 4; ++mb)
#pragma unroll
      for (int j = 0; j < 4; ++j) {
        const int idx = mb * 16 + fq * 4 + j;
        colf[mb][j] = ex2((float)(63 - idx) * lgf);
        colb[mb][j] = ex2((float)idx * lgb);
      }
  }
  const int ntile = Lk >> 6;
  const u16* kp[NKL];
  int kstep[NKL], ko[NKL];
  const u16* vp[2];
  int vo[2];
#pragma unroll
  for (int i = 0; i < NKL; ++i) {
    const int cid = tid + 256 * i;
    const int row = cid / KCH, cc = cid % KCH;
    ko[i] = row * KSTR + cc * 8;
    if (MODE == 0 && cc >= 8) { kp[i] = Kr + (size_t)row * 32 + (cc - 8) * 8; kstep[i] = 64 * 32; }
    else { kp[i] = Kn + (size_t)row * 64 + cc * 8; kstep[i] = 64 * 64; }
  }
#pragma unroll
  for (int i = 0; i < 2; ++i) {
    const int cid = tid + 256 * i;
    const int e = cid >> 3, cc = cid & 7;
    vo[i] = e * 72 + cc * 8;
    vp[i] = Vt + (size_t)e * Lk + cc * 8;
  }
  bf16x8 kregs[2][NKL], vregs[2][2];
  auto gload = [&](const int set) {
#pragma unroll
    for (int i = 0; i < NKL; ++i) { kregs[set][i] = *(const bf16x8*)kp[i]; kp[i] += kstep[i]; }
#pragma unroll
    for (int i = 0; i < 2; ++i) { vregs[set][i] = *(const bf16x8*)vp[i]; vp[i] += 64; }
  };
#pragma unroll 1
  for (int rep_ = 0; rep_ < (PROBE_ATT ? 2 : 1); ++rep_) {
  if (rep_) {
#pragma unroll
    for (int i = 0; i < NKL; ++i) kp[i] -= (size_t)kstep[i] * ntile;
#pragma unroll
    for (int i = 0; i < 2; ++i) vp[i] -= (size_t)64 * ntile;
  }
  gload(0);
  gload(1);
#pragma unroll 1
  for (int kt2 = 0; kt2 < ntile; kt2 += 2) {
#pragma unroll
  for (int hh = 0; hh < 2; ++hh) {
    const int kt = kt2 + hh;
    __syncthreads();
#pragma unroll
    for (int i = 0; i < NKL; ++i) *(bf16x8*)(sK + ko[i]) = kregs[hh][i];
#pragma unroll
    for (int i = 0; i < 2; ++i) *(bf16x8*)(sV + vo[i]) = vregs[hh][i];
    __syncthreads();
    if (kt + 2 < ntile) gload(hh);
    f32x4 s[4][2];
#pragma unroll
    for (int mb = 0; mb < 4; ++mb)
#pragma unroll
      for (int nb = 0; nb < 2; ++nb) s[mb][nb] = (f32x4){0.f, 0.f, 0.f, 0.f};
#pragma unroll
    for (int ks = 0; ks < KS; ++ks)
#pragma unroll
      for (int mb = 0; mb < 4; ++mb) {
        bf16x8 kf = *(const bf16x8*)(sK + (mb * 16 + fr) * KSTR + ks * 32 + fq * 8);
#pragma unroll
        for (int nb = 0; nb < 2; ++nb) s[mb][nb] = __builtin_amdgcn_mfma_f32_16x16x32_bf16(kf, qf[nb][ks], s[mb][nb], 0, 0, 0);
      }
    if (MODE == 0) {
#pragma unroll
      for (int nb = 0; nb < 2; ++nb) {
        float mx = -1e30f;
#pragma unroll
        for (int mb = 0; mb < 4; ++mb)
#pragma unroll
          for (int j = 0; j < 4; ++j) mx = fmaxf(mx, s[mb][nb][j]);
        mx = fmaxf(mx, __shfl_xor(mx, 16));
        mx = fmaxf(mx, __shfl_xor(mx, 32));
        if (!__all(mx - mrun[nb] <= 6.f)) {
          const float mn = fmaxf(mrun[nb], mx);
          const float alpha = ex2(mrun[nb] - mn);
          mrun[nb] = mn;
          lsum[nb] *= alpha;
#pragma unroll
          for (int eb = 0; eb < 4; ++eb) o[eb][nb] *= alpha;
        }
        const float mn = mrun[nb];
        float ps = 0.f;
#pragma unroll
        for (int mb = 0; mb < 4; ++mb)
#pragma unroll
          for (int j = 0; j < 4; ++j) { float pv = ex2(s[mb][nb][j] - mn); s[mb][nb][j] = pv; ps += pv; }
        lsum[nb] += ps;
      }
    } else {
#pragma unroll
      for (int nb = 0; nb < 2; ++nb) {
        const int tq = q0 + nb * 16 + fr;
        const int kbase = kt * 64;
        if (kbase + 63 < q0) {
          const float rowf = ex2((float)(tq - kbase - 63) * lgf);
#pragma unroll
          for (int mb = 0; mb < 4; ++mb)
#pragma unroll
            for (int j = 0; j < 4; ++j) s[mb][nb][j] *= rowf * colf[mb][j];
        } else if (kbase < L && kbase > q0 + 31) {
          const float rowb = ex2((float)(kbase - tq) * lgb);
#pragma unroll
          for (int mb = 0; mb < 4; ++mb)
#pragma unroll
            for (int j = 0; j < 4; ++j) s[mb][nb][j] *= rowb * colb[mb][j];
        } else if (kbase < L) {
#pragma unroll
          for (int mb = 0; mb < 4; ++mb)
#pragma unroll
            for (int j = 0; j < 4; ++j) {
              const int sk = kt * 64 + mb * 16 + fq * 4 + j;
              const int diff = tq - sk;
              float e = diff >= 0 ? (float)diff * lgf : (float)(-diff) * lgb;
              float dm = ex2(e);
              if (diff == 0) dm = 2.f;
              s[mb][nb][j] *= dm;
            }
        } else {
          const float dm = (kt * 64 == L) ? ex2((float)(tq + 1) * lgf) : ex2((float)(L - tq) * lgb);
#pragma unroll
          for (int mb = 0; mb < 4; ++mb)
#pragma unroll
            for (int j = 0; j < 4; ++j) s[mb][nb][j] *= dm;
        }
      }
    }
#pragma unroll
    for (int s2 = 0; s2 < 2; ++s2) {
      bf16x8 pf[2];
#pragma unroll
      for (int nb = 0; nb < 2; ++nb) {
        u32x4 pw;
        pw[0] = pk2(s[2 * s2][nb][0], s[2 * s2][nb][1]);
        pw[1] = pk2(s[2 * s2][nb][2], s[2 * s2][nb][3]);
        pw[2] = pk2(s[2 * s2 + 1][nb][0], s[2 * s2 + 1][nb][1]);
        pw[3] = pk2(s[2 * s2 + 1][nb][2], s[2 * s2 + 1][nb][3]);
        pf[nb] = __builtin_bit_cast(bf16x8, pw);
      }
#pragma unroll
      for (int eb = 0; eb < 4; ++eb) {
        const u16* vp = sV + (eb * 16 + fr) * 72 + s2 * 32 + fq * 4;
        bf16x4 lo = *(const bf16x4*)vp;
        bf16x4 hi = *(const bf16x4*)(vp + 16);
        bf16x8 vf;
        vf[0] = lo[0]; vf[1] = lo[1]; vf[2] = lo[2]; vf[3] = lo[3];
        vf[4] = hi[0]; vf[5] = hi[1]; vf[6] = hi[2]; vf[7] = hi[3];
#pragma unroll
        for (int nb = 0; nb < 2; ++nb) o[eb][nb] = __builtin_amdgcn_mfma_f32_16x16x32_bf16(vf, pf[nb], o[eb][nb], 0, 0, 0);
      }
    }
  }
  }
  }
  u16* cat = (u16*)(p.ws + WS_BIG + BG_CONCAT);
#pragma unroll
  for (int nb = 0; nb < 2; ++nb) {
    const int row = row_base(isl, b) + q0 + nb * 16 + fr;
    if (MODE == 0) {
      float ls = lsum[nb];
      ls += __shfl_xor(ls, 16);
      ls += __shfl_xor(ls, 32);
      const float inv = 1.f / ls;
#pragma unroll
      for (int eb = 0; eb < 4; ++eb)
        *(bf16x4*)(cat + (size_t)row * 1024 + 512 + h * 64 + eb * 16 + fq * 4) =
            pack4(o[eb][nb][0] * inv, o[eb][nb][1] * inv, o[eb][nb][2] * inv, o[eb][nb][3] * inv);
    } else {
      float sm = 0.f;
#pragma unroll
      for (int eb = 0; eb < 4; ++eb)
#pragma unroll
        for (int j = 0; j < 4; ++j) sm += o[eb][nb][j];
      sm += __shfl_xor(sm, 16);
      sm += __shfl_xor(sm, 32);
      const float mu = sm * (1.f / 64.f);
      float vr = 0.f;
#pragma unroll
      for (int eb = 0; eb < 4; ++eb)
#pragma unroll
        for (int j = 0; j < 4; ++j) { float d = o[eb][nb][j] - mu; vr += d * d; }
      vr += __shfl_xor(vr, 16);
      vr += __shfl_xor(vr, 32);
      const float rs = rsqrtf(vr * (1.f / 64.f) + EPS);
      const u16* rg = (const u16*)(p.ws + WS_BIG + BG_RG) + (size_t)row * 256 + h * 64;
#pragma unroll
      for (int eb = 0; eb < 4; ++eb) {
        bf16x4 g = *(const bf16x4*)(rg + eb * 16 + fq * 4);
        *(bf16x4*)(cat + (size_t)row * 1024 + h * 64 + eb * 16 + fq * 4) =
            pack4((o[eb][nb][0] - mu) * rs * bfs(g[0]), (o[eb][nb][1] - mu) * rs * bfs(g[1]),
                  (o[eb][nb][2] - mu) * rs * bfs(g[2]), (o[eb][nb][3] - mu) * rs * bfs(g[3]));
      }
    }
  }
}

DEVI void state_job(const Params& p, int l, int job, char* smem) {
  u16* sK = (u16*)smem;
  u16* sV = sK + 128 * 64;
  float* sW = (float*)(sV + 64 * 136);
  const int tid = otid();
  const int b = job >> 3, h = (job >> 1) & 3, dir = job & 1;
  const int bh = b * 4 + h;
  const u16* K = (const u16*)(p.ws + WS_BIG + BG_RKC) + (size_t)bh * 256 * 64;
  const u16* Vt = (const u16*)(p.ws + WS_BIG + BG_RVTC) + (size_t)bh * 64 * 256;
  const float dd = p.in[IX_DECAY][(l * 2 + dir) * 4 + h];
  const float lg = -__log2f(1.f + __expf(-dd));
  const int dk = tid >> 2, eg = tid & 3;
  float acc[16];
#pragma unroll
  for (int i = 0; i < 16; ++i) acc[i] = 0.f;
  __syncthreads();
  sW[tid] = ex2((float)(dir == 0 ? 255 - tid : tid) * lg);
  for (int hf = 0; hf < 2; ++hf) {
    __syncthreads();
    {
      bf16x8 tk[4], tv[4];
#pragma unroll
      for (int q = 0; q < 4; ++q) {
        const int i = tid + 256 * q;
        tk[q] = *(const bf16x8*)(K + (size_t)(hf * 128 + (i >> 3)) * 64 + (i & 7) * 8);
        tv[q] = *(const bf16x8*)(Vt + (size_t)(i >> 4) * 256 + hf * 128 + (i & 15) * 8);
      }
#pragma unroll
      for (int q = 0; q < 4; ++q) {
        const int i = tid + 256 * q;
        *(bf16x8*)(sK + (i >> 3) * 64 + (i & 7) * 8) = tk[q];
        *(bf16x8*)(sV + (i >> 4) * 136 + (i & 15) * 8) = tv[q];
      }
    }
    __syncthreads();
    for (int s8 = 0; s8 < 128; s8 += 8) {
      float kw[8];
#pragma unroll
      for (int e = 0; e < 8; ++e) kw[e] = bf2f(sK[(s8 + e) * 64 + dk]) * sW[hf * 128 + s8 + e];
#pragma unroll
      for (int i = 0; i < 16; ++i) {
        bf16x8 v = *(const bf16x8*)(sV + (eg * 16 + i) * 136 + s8);
#pragma unroll
        for (int e = 0; e < 8; ++e) acc[i] += kw[e] * bfs(v[e]);
      }
    }
  }
  float* o = p.out + OUT_ST + ((((size_t)(b * 2 + l) * 2 + dir) * 4 + h) * 64 + dk) * 64 + eg * 16;
#pragma unroll
  for (int i = 0; i < 16; i += 4) *(float4*)(o + i) = make_float4(acc[i], acc[i + 1], acc[i + 2], acc[i + 3]);
}

template <int CFG>
DEVI void hyena_job(const Params& p, int l, int order, int job, char* smem) {
  constexpr int L = CFG ? 2048 : 256, NB = CFG ? 8 : 16, RSTR = CFG ? 2304 : 512, NG = CFG ? 8 : 4, GSTEP = CFG ? 32 : 16;
  constexpr int NCH = CFG ? 6 : 1;
  const int tid = otid(), wid = tid >> 6, lane = tid & 63, fr = lane & 15, fq = lane >> 4;
  int c, T0;
  if (CFG) { c = job >> 1; T0 = (job & 1) * 1024; } else { c = job; T0 = 0; }
  u16* sU = (u16*)smem;
  u16* sF = sU + NB * RSTR;
  const u16* HUT = (const u16*)(p.ws + WS_BIG + BG_HUT) + (CFG ? (size_t)MC * 768 : 0);
  u16* Z1 = (u16*)(p.ws + WS_Z1) + (CFG ? (size_t)MC * 256 : 0);
  const u16* GR = (const u16*)(p.ws + WS_GRV) + (size_t)l * GRV_PER_LAYER + (CFG ? 0 : 2097152) + ((size_t)order * 256 + c) * (2 * L);
  auto ub = [&](int bi) { return bi * RSTR + (CFG ? 32 * (bi & 3) : 8 * bi) + 64; };
  bf16x8 clo = (bf16x8){0, 0, 0, 0, 0, 0, 0, 0}, chi = (bf16x8){0, 0, 0, 0, 0, 0, 0, 0};
  auto gl_chunk = [&](int ch) {
    if (tid < 67) {
      const int yb = CFG ? (3568 - T0 - 512 * ch) : -16;
      const int y8 = yb + 8 * tid;
      clo = (bf16x8){0, 0, 0, 0, 0, 0, 0, 0};
      chi = (bf16x8){0, 0, 0, 0, 0, 0, 0, 0};
      if (y8 >= 0 && y8 < 2 * L) clo = *(const bf16x8*)(GR + y8);
      if (y8 + 8 >= 0 && y8 + 8 < 2 * L) chi = *(const bf16x8*)(GR + y8 + 8);
    }
  };
  auto st_chunk = [&](int buf) {
    if (tid < 66) {
#pragma unroll
      for (int r = 0; r < 8; ++r) {
        bf16x8 w;
#pragma unroll
        for (int e = 0; e < 8; ++e) w[e] = (r + e < 8) ? clo[(r + e) & 7] : chi[(r + e) & 7];
        *(bf16x8*)(sF + buf * 4224 + r * 528 + 8 * tid) = w;
      }
    }
  };
  gl_chunk(0);
  constexpr int NIT = NB * (L / 8) / 256;
  bf16x8 uv[NIT];
  u16 ul[NIT], ur[NIT];
#pragma unroll
  for (int q = 0; q < NIT; ++q) {
    const int it = q * 256 + tid;
    const int bi = it / (L / 8), s8 = (it % (L / 8)) * 8;
    if (order == 0) {
      const u16* src = HUT + ((size_t)bi * 768 + c) * L;
      uv[q] = *(const bf16x8*)(src + s8);
      ul[q] = s8 > 0 ? src[s8 - 1] : (u16)0;
      ur[q] = s8 + 8 < L ? src[s8 + 8] : (u16)0;
    } else {
      uv[q] = *(const bf16x8*)(Z1 + ((size_t)bi * 256 + c) * L + s8);
      ul[q] = 0; ur[q] = 0;
    }
  }
  __syncthreads();
  for (int i = tid; i < NB * RSTR / 8; i += 256) *(bf16x8*)(sU + i * 8) = (bf16x8){0, 0, 0, 0, 0, 0, 0, 0};
  __syncthreads();
  {
    const float w0 = p.in[IX_HSW][(l * 3 + 0) * 768 + c], w1 = p.in[IX_HSW][(l * 3 + 1) * 768 + c],
                w2 = p.in[IX_HSW][(l * 3 + 2) * 768 + c], bs = p.in[IX_HSB][l * 768 + c];
#pragma unroll
    for (int q = 0; q < NIT; ++q) {
      const int it = q * 256 + tid;
      const int bi = it / (L / 8), s8 = (it % (L / 8)) * 8;
      bf16x8 ov;
      if (order == 0) {
        float x[10];
        x[0] = bf2f(ul[q]);
        x[9] = bf2f(ur[q]);
#pragma unroll
        for (int e = 0; e < 8; ++e) x[1 + e] = bfs(uv[q][e]);
#pragma unroll
        for (int e = 0; e < 8; ++e) ov[e] = (short)f2bf(w0 * x[e] + w1 * x[e + 1] + w2 * x[e + 2] + bs);
      } else {
        ov = uv[q];
      }
      *(bf16x8*)(sU + ub(bi) + s8) = ov;
    }
  }
  f32x4 acc[NG];
#pragma unroll
  for (int g = 0; g < NG; ++g) acc[g] = (f32x4){0.f, 0.f, 0.f, 0.f};
  const int bil = CFG ? (fr & 7) : fr;
  const int hfl = CFG ? (fr >> 3) : 0;
  const int ubl = ub(bil) + 16 * hfl + 8 * fq;
  const int rr = (16 - fr) & 7;
  const int tw = T0 + wid * (NG * GSTEP);
  st_chunk(0);
  __syncthreads();
  if (CFG) {
    auto win = [&](int d) {
      int slo = tw + 32 * d;
      const bool valid = (slo >= -32 && slo <= L - 32);
      slo = valid ? slo : -64;
      return *(const bf16x8*)(sU + ubl + slo);
    };
    bf16x8 ring[8];
    const int i0 = T0 / 32 - 63;
#pragma unroll
    for (int g = 1; g < 8; ++g) ring[(g - 1) & 7] = win(g - i0);
#pragma unroll 1
    for (int ch = 0; ch < NCH; ++ch) {
      if (ch + 1 < NCH) gl_chunk(ch + 1);
      const int ic0 = i0 + 16 * ch;
      const u16* fb = sF + (ch & 1) * 4224 + rr * 528;
#pragma unroll
      for (int ii = 0; ii < 16; ++ii) {
        const int i = ic0 + ii;
        const int rel0 = 32 * (15 - ii) + 16 - fr + 8 * fq;
        const bf16x8 af = *(const bf16x8*)(fb + (rel0 - rr));
        ring[(7 - ii) & 7] = win(-i);
#pragma unroll
        for (int g = 0; g < 8; ++g) acc[g] = __builtin_amdgcn_mfma_f32_16x16x32_bf16(af, ring[(g + 15 - ii) & 7], acc[g], 0, 0, 0);
      }
      if (ch + 1 < NCH) st_chunk((ch + 1) & 1);
      __syncthreads();
    }
  } else {
#pragma unroll 1
  for (int ch = 0; ch < NCH; ++ch) {
    if (ch + 1 < NCH) { gl_chunk(ch + 1); st_chunk((ch + 1) & 1); }
    const int ic0 = (CFG ? (T0 / 32 - 63) : -7) + 16 * ch;
    const u16* fb = sF + (ch & 1) * 4224 + rr * 528;
#pragma unroll 2
    for (int ii = 0; ii < 16; ++ii) {
      const int i = ic0 + ii;
      const int rel0 = 32 * (15 - ii) + 16 - fr + 8 * fq;
      const bf16x8 af = *(const bf16x8*)(fb + (rel0 - rr));
      bf16x8 bv[NG];
#pragma unroll
      for (int g = 0; g < NG; ++g) {
        int slo = tw + g * GSTEP - 32 * i;
        const bool valid = CFG ? (slo >= -32 && slo <= L - 32) : (slo >= -16 && slo <= L - 16);
        slo = valid ? slo : -64;
        bv[g] = *(const bf16x8*)(sU + ubl + slo);
      }
#pragma unroll
      for (int g = 0; g < NG; ++g) acc[g] = __builtin_amdgcn_mfma_f32_16x16x32_bf16(af, bv[g], acc[g], 0, 0, 0);
    }
    __syncthreads();
  }
  }
  const int xc = 256 * (1 + order) + c;
  const float w0 = p.in[IX_HSW][(l * 3 + 0) * 768 + xc], w1 = p.in[IX_HSW][(l * 3 + 1) * 768 + xc],
              w2 = p.in[IX_HSW][(l * 3 + 2) * 768 + xc], bs = p.in[IX_HSB][l * 768 + xc];
  const float dsk = p.in[IX_HBIAS][(l * 2 + order) * 256 + c];
  const u16* xrow = HUT + ((size_t)bil * 768 + xc) * L;
  u16* cat = (u16*)(p.ws + WS_BIG + BG_CONCAT);
  bf16x4 xm[NG];
  u16 xl[NG], xr[NG];
#pragma unroll
  for (int g = 0; g < NG; ++g) {
    const int tb = tw + g * GSTEP + 16 * hfl + fq * 4;
    xm[g] = *(const bf16x4*)(xrow + tb);
    xl[g] = (tb > 0) ? xrow[tb - 1] : (u16)0;
    xr[g] = (tb + 4 < L) ? xrow[tb + 4] : (u16)0;
  }
#pragma unroll
  for (int g = 0; g < NG; ++g) {
    const int tb = tw + g * GSTEP + 16 * hfl + fq * 4;
    float x[6];
    x[0] = bf2f(xl[g]); x[5] = bf2f(xr[g]);
#pragma unroll
    for (int e = 0; e < 4; ++e) x[1 + e] = bfs(xm[g][e]);
    float z[4];
#pragma unroll
    for (int j = 0; j < 4; ++j) {
      float gate = w0 * x[j] + w1 * x[j + 1] + w2 * x[j + 2] + bs;
      float uin = bf2f(sU[ub(bil) + tb + j]);
      z[j] = gate * (acc[g][j] + dsk * uin);
    }
    if (order == 0) {
      *(bf16x4*)(Z1 + ((size_t)bil * 256 + c) * L + tb) = pack4(z[0], z[1], z[2], z[3]);
    } else {
      const int rb = row_base(CFG, bil) + tb;
#pragma unroll
      for (int j = 0; j < 4; ++j) cat[(size_t)(rb + j) * 1024 + 768 + c] = f2bf(z[j]);
    }
  }
}

constexpr int NPHASE = 18;

#define JOBLOOP(START, COUNT, ...)                                    \
  {                                                                   \
    int _f = (int)blockIdx.x - (int)((START) % G);                    \
    if (_f < 0) _f += G;                                              \
    for (int job = _f; job < (COUNT); job += G) { __VA_ARGS__; }      \
  }
#define PJOBLOOP(ID, START, COUNT, ...) { JOBLOOP(START, COUNT, __VA_ARGS__) if (PROBE_SUB == ID) { __syncthreads(); JOBLOOP(START, COUNT, __VA_ARGS__) } }

template <int S>
DEVI void stage_loop(const Params& p, int l, char* smem) {
  char* ws = p.ws;
  const int G = gridDim.x;
  const u16* HB = (const u16*)(ws + WS_HB);
  if (S == 0) {
    PJOBLOOP(9, 0, 384, mod_job(p, job, smem));
    PJOBLOOP(10, 384, 288, hymlp_job(p, job, smem));
    JOBLOOP(672, NCONV_A, conv_group_a(p, 0, job, smem));
    JOBLOOP(672 + NCONV_A, NCONV_B, conv_group_b(p, 0, job, smem));
    JOBLOOP(672 + NCONV_A + NCONV_B, 2304, table_job(p, job));
    JOBLOOP(2976 + NCONV_A + NCONV_B, 256, cc_job(p, job));
  } else if (S == 1) {
    JOBLOOP(0, 288, hyfin_job(p, job, smem));
    JOBLOOP(288, 2560, rowop_job(p, 0, 0, job));
  } else if (S == 2) {
    PJOBLOOP(11, 0, 1760, gemm_job<EPI_WIN, 8>(p, l, HB, 1024, (const u16*)(ws + WS_WIN), 1024, 1024, job % 80, job / 80, 0, smem));
    JOBLOOP(1760, 32, l1extra_job(p, l, job));
  } else if (S == 3) {
    PJOBLOOP(5, 0, 512, hyena_job<1>(p, l, 0, job, smem));
    PJOBLOOP(6, 512, 256, gemm_job<EPI_FOUR, 4>(p, l, (const u16*)(ws + WS_TABL), 4096,
                                         (const u16*)(ws + WS_BIG + BG_XCS) + (size_t)MC * 512 + (size_t)(job >> 5) * 256 * 4096,
                                         4096, 4096, (job >> 1) & 15, job & 1, MC + (job >> 5) * 2048, smem));
    PJOBLOOP(7, 768, 480, gemm_job<EPI_MQ, 4>(p, l, (const u16*)(ws + WS_BIG + BG_CQ), 256, (const u16*)(ws + WS_WUQ), 256, 256, job % 160, job / 160, 0, smem));
    PJOBLOOP(8, 1248, 320, gemm_job<EPI_MKV, 8>(p, l, (const u16*)(ws + WS_BIG + BG_CKV), 128, (const u16*)(ws + WS_WUKV), 128, 128, job % 80, job / 80, 0, smem));
    JOBLOOP(1568, 64, gemm_job<EPI_MKVC, 4>(p, l, (const u16*)(ws + WS_CC) + (size_t)l * 2048 * 128, 128, (const u16*)(ws + WS_WUKVP), 128, 128, job & 15, job >> 4, 0, smem));
    JOBLOOP(1632, 64, gemm_job<EPI_FOUR, 4>(p, l, (const u16*)(ws + WS_TABC), 512, (const u16*)(ws + WS_BIG + BG_XCS) + (size_t)(job >> 2) * 256 * 512,
                                         512, 512, (job >> 1) & 1, job & 1, (job >> 2) * 256, smem));
    JOBLOOP(1696, 256, hyena_job<0>(p, l, 0, job, smem));
  } else if (S == 4) {
    PJOBLOOP(0, 0, 128, state_job(p, l, job, smem));
    PJOBLOOP(1, 128, 640, attn_job<0>(p, l, job, smem));
    PJOBLOOP(2, 768, 640, attn_job<1>(p, l, job, smem));
    PJOBLOOP(3, 1408, 512, hyena_job<1>(p, l, 1, job, smem));
    PJOBLOOP(4, 1920, 256, hyena_job<0>(p, l, 1, job, smem));
  } else if (S == 5) {
    PJOBLOOP(12, 0, 640, gemm_job<EPI_WOUT, 8>(p, l, (const u16*)(ws + WS_BIG + BG_CONCAT), 1024, (const u16*)(ws + WS_WOUT), 1024, 1024, (job & 7) + 8 * (job >> 6), (job >> 3) & 7, 0, smem));
  } else if (S == 6) {
    const int nc = (l == 0) ? NCONV_A : 0;
    JOBLOOP(0, nc, conv_group_a(p, 1, job, smem));
    JOBLOOP(nc, 2560, rowop_job(p, l, 1, job));
  } else if (S == 7) {
    PJOBLOOP(13, 0, 3520, gemm_job<EPI_FFNUP, 8>(p, l, HB, 1024, (const u16*)(ws + WS_WGU), 1024, 1024, job % 80, job / 80, 0, smem));
  } else if (S == 8) {
    PJOBLOOP(14, 0, 640, gemm_job<EPI_FFNDN, 8>(p, l, (const u16*)(ws + WS_BIG + BG_ACT), 2816, (const u16*)(ws + WS_WD), 2816, 2816, (job & 7) + 8 * (job >> 6), (job >> 3) & 7, 0, smem));
  } else {
    const int nc = (l == 0) ? NCONV_B : 0;
    JOBLOOP(0, nc, conv_group_b(p, 1, job, smem));
    JOBLOOP(nc, 2560, rowop_job(p, l, 2, job));
  }
}

#if !SINGLE_LAUNCH
template <int S>
__global__ void __launch_bounds__(256, 2) stage_kernel(Params p, int l) {
  __shared__ __attribute__((aligned(16))) char smem[SMEM_BYTES];
  stage_loop<S>(p, l, smem);
}

#else
__global__ void __launch_bounds__(256, 2) mega(Params p) {
  __shared__ __attribute__((aligned(16))) char smem[SMEM_BYTES];
  cg::grid_group grid = cg::this_grid();
  if (p.out == nullptr) grid.sync();
  volatile LAS unsigned* xbw = (volatile LAS unsigned*)(smem + SMEM_BYTES - 16);
  if (threadIdx.x == 0) { xbw[0] = 0u; xbw[1] = 0u; }
  __syncthreads();
  XcdBarrier xb = xcd_barrier_post((unsigned*)(p.ws + WS_BAR), xbw);
  for (int i = 0; i < PROBE_SYNCS; ++i) xcd_barrier(xb);
#define RUNSTG(S, L) { stage_loop<S>(p, L, smem); if (PROBE_ST == S && (S != 6 || L == 0)) { xcd_barrier(xb); stage_loop<S>(p, L, smem); } }
  RUNSTG(0, 0); xcd_barrier(xb);
  RUNSTG(1, 0); xcd_barrier(xb);
  for (int l = 0; l < 2; ++l) {
    RUNSTG(2, l); xcd_barrier(xb);
    RUNSTG(3, l); xcd_barrier(xb);
    RUNSTG(4, l); xcd_barrier(xb);
    RUNSTG(5, l); xcd_barrier(xb);
    RUNSTG(6, l); xcd_barrier(xb);
    RUNSTG(7, l); xcd_barrier(xb);
    RUNSTG(8, l); xcd_barrier(xb);
    stage_loop<9>(p, l, smem);
    if (l == 0) xcd_barrier(xb);
  }
}

#endif

extern "C" void kernel_launch(void* const* d_in, const int* in_sizes, int n_in, void* d_out, int out_size, void* d_ws,
                              size_t ws_size, hipStream_t stream) {
  Params p{};
  for (int i = 0; i < N_IN; ++i) p.in[i] = (const float*)d_in[i];
  p.out = (float*)d_out;
  p.ws = (char*)d_ws;
  if (ws_size < WS_TOTAL) fprintf(stderr, "workspace too small: %zu < %zu\n", ws_size, (size_t)WS_TOTAL);
  static int grid_blocks = 0;
  if (!grid_blocks) {
    int dev = 0, cus = 0, per_cu = 0;
    (void)hipGetDevice(&dev);
    (void)hipDeviceGetAttribute(&cus, hipDeviceAttributeMultiprocessorCount, dev);
#if SINGLE_LAUNCH
    (void)hipOccupancyMaxActiveBlocksPerMultiprocessor(&per_cu, mega, 256, 0);
#else
    per_cu = 2;
#endif
    if (per_cu < 1) per_cu = 1;
    if (per_cu > 2) per_cu = 2;
    grid_blocks = cus * per_cu;
  }
#if SINGLE_LAUNCH
  (void)hipMemsetAsync(p.ws + WS_BAR, 0, XCD_BAR_WORDS * 4, stream);
  void* args[] = {&p};
  hipError_t e = hipLaunchCooperativeKernel((void*)mega, dim3(grid_blocks), dim3(256), args, 0, stream);
  if (e != hipSuccess) fprintf(stderr, "cooperative launch failed: %s (grid %d)\n", hipGetErrorString(e), grid_blocks);
#else
  const dim3 g(grid_blocks), t(256);
#define RUNST(S, L) for (int r_ = 0; r_ < ((PROBE_STAGE == S) ? 2 : 1); ++r_) stage_kernel<S><<<g, t, 0, stream>>>(p, L)
  RUNST(0, 0);
  RUNST(1, 0);
  for (int l = 0; l < 2; ++l) {
    RUNST(2, l);
    RUNST(3, l);
    RUNST(4, l);
    RUNST(5, l);
    RUNST(6, l);
    RUNST(7, l);
    RUNST(8, l);
    RUNST(9, l);
  }
#endif
}
```

```cpp
#include <hip/hip_runtime.h>
#include <hip/hip_cooperative_groups.h>
#include <cstdio>
namespace cg = cooperative_groups;

#ifndef SINGLE_LAUNCH
#define SINGLE_LAUNCH 1
#endif
#ifndef PROBE_STAGE
#define PROBE_STAGE -1
#endif
#ifndef PROBE_SUB
#define PROBE_SUB -1
#endif
#ifndef PROBE_G
#define PROBE_G 0
#endif
#ifndef PROBE_ST
#define PROBE_ST -1
#endif
#ifndef PROBE_ATT
#define PROBE_ATT 0
#endif
#ifndef PROBE_SYNCS
#define PROBE_SYNCS 0
#endif

typedef unsigned short u16;
typedef __attribute__((ext_vector_type(8))) short bf16x8;
typedef __attribute__((ext_vector_type(4))) short bf16x4;
typedef __attribute__((ext_vector_type(4))) float f32x4;
#define DEVI __device__ __forceinline__

enum { IX_XP = 0, IX_XS, IX_CCKV, IX_CKR, IX_STATE, IX_C, IX_CCTX, IX_WADA, IX_BADA, IX_NORMG, IX_WIN, IX_WOUT,
       IX_DECAY, IX_QNORM, IX_KVNORM, IX_WUQ, IX_WUKV, IX_HSW, IX_HSB, IX_HW1, IX_HB1, IX_HW2, IX_HB2, IX_HW3,
       IX_HBIAS, IX_WG, IX_WU, IX_WDN, N_IN };

struct Params {
  const float* in[N_IN];
  float* out;
  char* ws;
};

constexpr int MC = 4096, MT = 20480;
constexpr float EPS = 1e-6f;
constexpr float LOG2_1E4 = 13.287712379549449f;
constexpr float LOG2E = 1.4426950408889634f;

constexpr size_t OUT_CKV = (size_t)MT * 1024;
constexpr size_t OUT_KR = OUT_CKV + (size_t)16 * 2 * 256 * 128;
constexpr size_t OUT_ST = OUT_KR + (size_t)16 * 2 * 256 * 32;

constexpr size_t al256(size_t x) { return (x + 255) & ~(size_t)255; }
constexpr size_t WS_WIN = 0;
constexpr size_t WS_WOUT = WS_WIN + (size_t)2816 * 1024 * 2;
constexpr size_t WS_WGU = WS_WOUT + (size_t)1024 * 1024 * 2;
constexpr size_t WS_WD = WS_WGU + (size_t)5632 * 1024 * 2;
constexpr size_t WS_WUQ = WS_WD + (size_t)1024 * 2816 * 2;
constexpr size_t WS_WUKV = WS_WUQ + (size_t)384 * 256 * 2;
constexpr size_t WS_WUKVP = WS_WUKV + (size_t)512 * 128 * 2;
constexpr size_t WS_TABL = WS_WUKVP + (size_t)512 * 128 * 2;
constexpr size_t WS_TABC = WS_TABL + (size_t)2048 * 4096 * 2;
constexpr size_t WS_MOD = WS_TABC + (size_t)256 * 512 * 2;
constexpr size_t WS_GRV = WS_MOD + al256((size_t)2 * 9 * 6144 * 4);
constexpr size_t GRV_PER_LAYER = 2359296;
constexpr size_t WS_CC = WS_GRV + (size_t)2 * GRV_PER_LAYER * 2;
constexpr size_t WS_HB = WS_CC + (size_t)2 * 2048 * 128 * 2;
constexpr size_t WS_Z1 = WS_HB + (size_t)MT * 1024 * 2;
constexpr size_t WS_BIG = WS_Z1 + (size_t)MT * 256 * 2;
constexpr size_t HB_MQ = 0;
constexpr size_t HB_MKNC = HB_MQ + (size_t)MT * 4 * 96 * 2;
constexpr size_t HB_MKNL = HB_MKNC + (size_t)64 * 256 * 64 * 2;
constexpr size_t HB_MVTC = HB_MKNL + (size_t)32 * 2304 * 64 * 2;
constexpr size_t HB_MVTL = HB_MVTC + (size_t)64 * 64 * 256 * 2;
constexpr size_t HB_END = HB_MVTL + (size_t)32 * 64 * 2304 * 2;
static_assert(HB_END <= (size_t)MT * 1024 * 2, "HB overflow");
constexpr size_t BG_CONCAT = 0;
constexpr size_t BG_RQ = BG_CONCAT + (size_t)MT * 1024 * 2;
constexpr size_t BG_RKC = BG_RQ + (size_t)MT * 256 * 2;
constexpr size_t BG_RKL = BG_RKC + (size_t)64 * 256 * 64 * 2;
constexpr size_t BG_RVTC = BG_RKL + (size_t)32 * 2176 * 64 * 2;
constexpr size_t BG_RVTL = BG_RVTC + (size_t)64 * 64 * 256 * 2;
constexpr size_t BG_RG = BG_RVTL + (size_t)32 * 64 * 2176 * 2;
constexpr size_t BG_XCS = BG_RG + (size_t)MT * 256 * 2;
constexpr size_t BG_CQ = BG_XCS + (size_t)MT * 512 * 2;
constexpr size_t BG_CKV = BG_CQ + (size_t)MT * 256 * 2;
constexpr size_t BG_HUT = BG_CKV + (size_t)MT * 128 * 2;
constexpr size_t BG_KRAC = BG_HUT + (size_t)MT * 768 * 2;
constexpr size_t BG_KRAL = BG_KRAC + (size_t)16 * 256 * 32 * 2;
constexpr size_t BG_END = BG_KRAL + (size_t)8 * 2304 * 32 * 2;
constexpr size_t BG_ACT = 0;
constexpr size_t BG_HF = 0;
static_assert((size_t)MT * 2816 * 2 <= BG_END, "act alias");
constexpr size_t WS_BAR = WS_BIG + BG_END;
constexpr size_t WS_PS = WS_BAR + 16384;
constexpr size_t WS_TOTAL = WS_PS + (size_t)288 * 1024 * 4;

constexpr int SMEM_BYTES = 74 * 1024;

typedef __attribute__((ext_vector_type(2))) float f32x2;
typedef __attribute__((ext_vector_type(2))) __bf16 bfx2;
DEVI unsigned pk2(float a, float b) {
  f32x2 v = {a, b};
  bfx2 r = __builtin_convertvector(v, bfx2);
  return __builtin_bit_cast(unsigned, r);
}
DEVI u16 f2bf(float f) { return (u16)(pk2(f, f) & 0xffffu); }
DEVI float bf2f(u16 h) { return __uint_as_float(((unsigned)h) << 16); }
DEVI float bfs(short h) { return __uint_as_float(((unsigned)(u16)h) << 16); }
DEVI float siluf(float x) { return x * __builtin_amdgcn_rcpf(1.f + __expf(-x)); }
DEVI float ex2(float x) { return __builtin_amdgcn_exp2f(x); }
typedef __attribute__((ext_vector_type(2))) unsigned u32x2;
typedef __attribute__((ext_vector_type(4))) unsigned u32x4;
DEVI bf16x4 pack4(float a, float b, float c, float d) {
  u32x2 r;
  r[0] = pk2(a, b); r[1] = pk2(c, d);
  return __builtin_bit_cast(bf16x4, r);
}
DEVI void glds16(const void* g, void* l) {
  __builtin_amdgcn_global_load_lds((const __attribute__((address_space(1))) unsigned*)g,
                                   (__attribute__((address_space(3))) unsigned*)l, 16, 0, 0);
}
DEVI int otid() { int t = threadIdx.x; asm volatile("" : "+v"(t)); return t; }
template <int N> DEVI void wait_vm() { asm volatile("s_waitcnt vmcnt(%0)" ::"n"(N) : "memory"); }
DEVI int row_base(int isl, int b) { return isl ? (MC + b * 2048) : (b * 256); }


#define XB_TMO      128
#define XB_XCNT(j)  (256  + 64 * (j))
#define XB_XSUB(j)  (1280 + 64 * (j))
#define XB_XGEN(j)  (2304 + 64 * (j))
#define XB_TOP      3328
#define XB_TOPGEN   3392
#define XCD_BAR_WORDS 3456
#define XB_SPIN_CAP (1u << 20)
#define LAS __attribute__((address_space(3)))
DEVI unsigned xb_ld(unsigned* p) { return __hip_atomic_load(p, __ATOMIC_RELAXED, __HIP_MEMORY_SCOPE_AGENT); }
DEVI unsigned xb_add(unsigned* p, unsigned v) { return __hip_atomic_fetch_add(p, v, __ATOMIC_RELAXED, __HIP_MEMORY_SCOPE_AGENT); }
DEVI unsigned xb_xcc_id() { return (unsigned)__builtin_amdgcn_s_getreg((3 << 11) | 20) & 0xFu; }
#define XB_SPIN(cond, bar) do { unsigned _sp = 0; while (cond) { __builtin_amdgcn_s_sleep(1); \
    if ((++_sp & 255u) == 0u) { if (xb_ld(&(bar)[XB_TMO])) break; if (_sp > XB_SPIN_CAP) { atomicAdd(&(bar)[XB_TMO], 1u); break; } } } } while (0)
struct XcdBarrier { unsigned* bar; unsigned x; volatile LAS unsigned* st; };
DEVI XcdBarrier xcd_barrier_post(unsigned* bar, volatile LAS unsigned* st) {
  XcdBarrier b; b.bar = bar; b.x = xb_xcc_id(); b.st = st;
  if (threadIdx.x == 0) (void)xb_add(&bar[XB_XCNT(b.x)], 1u);
  return b;
}
DEVI void xcd_barrier_complete(unsigned* bar, unsigned x, unsigned& nloc, unsigned& nx) {
  const unsigned G = gridDim.x * gridDim.y * gridDim.z;
  unsigned sum, cnt, mine, sp = 0u;
  for (;;) {
    sum = 0u; cnt = 0u; mine = 0u;
#pragma unroll
    for (unsigned j = 0; j < 16; ++j) { const unsigned c = xb_ld(&bar[XB_XCNT(j)]); sum += c; cnt += (c > 0u) ? 1u : 0u; mine = (j == x) ? c : mine; }
    if (sum == G) break;
    __builtin_amdgcn_s_sleep(1);
    if ((++sp & 255u) == 0u) { if (xb_ld(&bar[XB_TMO])) break; if (sp > XB_SPIN_CAP) { atomicAdd(&bar[XB_TMO], 1u); break; } }
  }
  nloc = mine > 0u ? mine : 1u; nx = cnt > 0u ? cnt : 1u;
}
DEVI void xcd_barrier(const XcdBarrier& b) {
  asm volatile("s_waitcnt vmcnt(0)" ::: "memory");
  __syncthreads();
  if (threadIdx.x == 0) {
    unsigned* bar = b.bar;
    __builtin_amdgcn_s_waitcnt(0);
    unsigned nloc = b.st[0], nx = b.st[1];
    if (nloc == 0u) { xcd_barrier_complete(bar, b.x, nloc, nx); b.st[0] = nloc; b.st[1] = nx; }
    const unsigned old = xb_add(&bar[XB_XSUB(b.x)], 1u);
    const unsigned gen = old / nloc;
    if (old + 1u == (gen + 1u) * nloc) {
      __builtin_amdgcn_fence(__ATOMIC_RELEASE, "agent");
      asm volatile("s_waitcnt vmcnt(0)" ::: "memory");
      const unsigned og = xb_add(&bar[XB_TOP], 1u);
      const unsigned tg = og / nx;
      if (og + 1u == (tg + 1u) * nx) xb_add(&bar[XB_TOPGEN], 1u);
      else XB_SPIN(xb_ld(&bar[XB_TOPGEN]) == tg, bar);
      __builtin_amdgcn_fence(__ATOMIC_ACQUIRE, "agent");
      xb_add(&bar[XB_XGEN(b.x)], 1u);
      asm volatile("s_waitcnt vmcnt(0)" ::: "memory");
    } else {
      XB_SPIN(xb_ld(&bar[XB_XGEN(b.x)]) == gen, bar);
      __builtin_amdgcn_fence(__ATOMIC_ACQUIRE, "agent");
      asm volatile("s_waitcnt vmcnt(0)" ::: "memory");
    }
  }
  __syncthreads();
}

enum { CW_WIN = 0, CW_WOUT, CW_WUQ, CW_WUKV, CW_WGU, CW_WD };

struct ConvSrc { const float* ptr; int ld; float scale; };
DEVI ConvSrc conv_src(const Params& p, int l, int which, int n) {
  ConvSrc s; s.scale = 1.f;
  switch (which) {
    case CW_WIN: {
      const float* w = p.in[IX_WIN] + (size_t)l * 1024 * 2464;
      s.ld = 2464;
      int col;
      if (n < 1024) { col = n; if (n >= 256 && n < 512) s.scale = 0.125f; }
      else if (n < 1536) col = 1024 + (((n - 1024) >> 6) & 3) * 64 + (n & 63);
      else if (n < 1792) col = 1280 + (n - 1536);
      else if (n < 2560) col = 1696 + (n - 1792);
      else if (n < 2688) col = 1536 + (n - 2560);
      else if (n < 2720) col = 1664 + (n - 2688);
      else { col = 0; s.scale = 0.f; }
      s.ptr = w + col;
      break;
    }
    case CW_WOUT: s.ptr = p.in[IX_WOUT] + (size_t)l * 1024 * 1024 + n; s.ld = 1024; break;
    case CW_WUQ: s.ptr = p.in[IX_WUQ] + (size_t)l * 256 * 384 + n; s.ld = 384; s.scale = 0.10206207261596577f * LOG2E; break;
    case CW_WUKV: s.ptr = p.in[IX_WUKV] + (size_t)l * 128 * 512 + n; s.ld = 512; break;
    case CW_WGU: {
      int tile = n >> 7, within = n & 127;
      int wcq = within >> 6, q = (within & 63) >> 4, i = within & 15;
      int ffcol = tile * 64 + wcq * 32 + (q >> 1) * 16 + i;
      const float* w = (q & 1) ? p.in[IX_WU] : p.in[IX_WG];
      s.ptr = w + (size_t)l * 1024 * 2816 + ffcol; s.ld = 2816;
      break;
    }
    default: s.ptr = p.in[IX_WDN] + (size_t)l * 2816 * 1024 + n; s.ld = 1024; break;
  }
  return s;
}

DEVI void conv_job(const Params& p, int l, int which, int tile, char* smem) {
  float* st = (float*)smem;
  float* trig = st + 64 * 65;
  int K;
  u16* dst;
  switch (which) {
    case CW_WIN: K = 1024; dst = (u16*)(p.ws + WS_WIN); break;
    case CW_WOUT: K = 1024; dst = (u16*)(p.ws + WS_WOUT); break;
    case CW_WUQ: K = 256; dst = (u16*)(p.ws + WS_WUQ); break;
    case CW_WUKV: K = 128; dst = (u16*)(p.ws + WS_WUKV); break;
    case CW_WGU: K = 1024; dst = (u16*)(p.ws + WS_WGU); break;
    default: K = 2816; dst = (u16*)(p.ws + WS_WD); break;
  }
  const int ktiles = K >> 6;
  const int nt = tile / ktiles, kt = tile % ktiles;
  const int n0 = nt * 64, k0 = kt * 64;
  const int tid = otid();
  const bool four = (which == CW_WIN) && (n0 >= 1024) && (n0 < 1536);
  __syncthreads();
  {
    const int nn = tid & 63, kq = tid >> 6;
    const ConvSrc cs = conv_src(p, l, which, n0 + nn);
    const float* sp = cs.ptr + (size_t)(k0 + kq) * cs.ld;
    float v[16];
#pragma unroll
    for (int it = 0; it < 16; ++it) v[it] = sp[(size_t)(it * 4) * cs.ld];
#pragma unroll
    for (int it = 0; it < 16; ++it) {
      float x = v[it] * cs.scale;
      if (which == CW_WUQ) x *= p.in[IX_QNORM][l * 256 + k0 + it * 4 + kq];
      st[(it * 4 + kq) * 65 + nn] = x;
    }
  }
  if (four && tid < 64) {
    float fr = (float)tid * (1.f / 64.f);
    trig[tid] = (n0 >= 1280) ? __builtin_amdgcn_sinf(fr) : __builtin_amdgcn_cosf(fr);
  }
  __syncthreads();
#pragma unroll 1
  for (int it = 0; it < 16; ++it) {
    int idx = it * 256 + tid;
    int nn = idx >> 6, kk = idx & 63;
    float v;
    if (four) {
      float a = 0.f;
#pragma unroll 4
      for (int i = 0; i < 64; ++i) a += st[kk * 65 + i] * trig[(i * nn) & 63];
      v = a * 0.125f;
    } else {
      v = st[kk * 65 + nn];
    }
    if (which == CW_WUKV) {
      ((u16*)(p.ws + WS_WUKVP))[(size_t)(n0 + nn) * K + k0 + kk] = f2bf(v);
      v *= p.in[IX_KVNORM][l * 128 + k0 + kk];
    }
    dst[(size_t)(n0 + nn) * K + k0 + kk] = f2bf(v);
  }
}
constexpr int NCONV_A = 704 + 256 + 24 + 16;
constexpr int NCONV_B = 1408 + 704;
DEVI void conv_group_a(const Params& p, int l, int job, char* smem) {
  if (job < 704) conv_job(p, l, CW_WIN, job, smem);
  else if (job < 960) conv_job(p, l, CW_WOUT, job - 704, smem);
  else if (job < 984) conv_job(p, l, CW_WUQ, job - 960, smem);
  else conv_job(p, l, CW_WUKV, job - 984, smem);
}
DEVI void conv_group_b(const Params& p, int l, int job, char* smem) {
  if (job < 1408) conv_job(p, l, CW_WGU, job, smem);
  else conv_job(p, l, CW_WD, job - 1408, smem);
}

DEVI void table_job(const Params& p, int job) {
  const int tid = otid();
  if (job < 2048) {
    const int t = job;
    u16* row = (u16*)(p.ws + WS_TABL) + (size_t)t * 4096;
    const float sc = 0.022097086912079608f;
    for (int it = 0; it < 16; ++it) {
      int k = it * 256 + tid;
      int kk = k & 2047;
      float fr = (float)((t * kk) & 2047) * (1.f / 2048.f);
      float v = (k >= 2048) ? -__builtin_amdgcn_sinf(fr) : __builtin_amdgcn_cosf(fr);
      row[k] = f2bf(v * sc);
    }
  } else {
    const int t = job - 2048;
    u16* row = (u16*)(p.ws + WS_TABC) + (size_t)t * 512;
    for (int it = 0; it < 2; ++it) {
      int k = it * 256 + tid;
      int kk = k & 255;
      float fr = (float)((t * kk) & 255) * (1.f / 256.f);
      float v = (k >= 256) ? -__builtin_amdgcn_sinf(fr) : __builtin_amdgcn_cosf(fr);
      row[k] = f2bf(v * 0.0625f);
    }
  }
}

DEVI void mod_job(const Params& p, int job, char* smem) {
  float* sc = (float*)smem;
  float* red = sc + 9 * 1024;
  const int tid = otid();
  const int l = job / 192, n0 = (job % 192) * 32;
  __syncthreads();
  {
    float cv[36];
#pragma unroll
    for (int q = 0; q < 36; ++q) {
      const int i = tid + 256 * q;
      const int bi = i >> 10, k = i & 1023;
      cv[q] = (bi == 0) ? p.in[IX_CCTX][k] : p.in[IX_C][(bi - 1) * 1024 + k];
    }
#pragma unroll
    for (int q = 0; q < 36; ++q) sc[tid + 256 * q] = siluf(cv[q]);
  }
  __syncthreads();
  const int col = tid & 31, kg = tid >> 5;
  float acc[9];
#pragma unroll
  for (int i = 0; i < 9; ++i) acc[i] = 0.f;
  const float* w = p.in[IX_WADA] + (size_t)l * 1024 * 6144 + n0 + col + (size_t)(kg * 128) * 6144;
#pragma unroll 1
  for (int k8 = 0; k8 < 128; k8 += 32) {
    float wv[32];
#pragma unroll
    for (int e = 0; e < 32; ++e) wv[e] = w[(size_t)(k8 + e) * 6144];
#pragma unroll
    for (int e = 0; e < 32; ++e)
#pragma unroll
      for (int i = 0; i < 9; ++i) acc[i] += sc[i * 1024 + kg * 128 + k8 + e] * wv[e];
  }
#pragma unroll
  for (int i = 0; i < 9; ++i) red[(kg * 9 + i) * 32 + col] = acc[i];
  __syncthreads();
  float* mod = (float*)(p.ws + WS_MOD);
  for (int i = tid; i < 9 * 32; i += 256) {
    int bi = i >> 5, c = i & 31;
    float v = p.in[IX_BADA][l * 6144 + n0 + c];
#pragma unroll
    for (int g = 0; g < 8; ++g) v += red[(g * 9 + bi) * 32 + c];
    mod[((size_t)l * 9 + bi) * 6144 + n0 + c] = v;
  }
}

DEVI void hymlp_job(const Params& p, int job, char* smem) {
  float* z = (float*)smem;
  float* h1 = z + 16 * 34;
  float* h2 = h1 + 16 * 64;
  const int tid = otid();
  const int l = job / 144, rj = job % 144;
  const int cfg = rj < 128 ? 1 : 0;
  const int pos0 = cfg ? rj * 16 : (rj - 128) * 16;
  const int L = cfg ? 2048 : 256;
  const int r0 = cfg ? pos0 : 2048 + pos0;
  __syncthreads();
  for (int i = tid; i < 16 * 33; i += 256) {
    const int pi = i / 33, q = i % 33;
    const int pos = pos0 + pi;
    float v;
    if (q == 0) v = (float)pos / (float)L;
    else {
      int band = (q <= 16) ? q : q - 16;
      float fr = (float)((pos * band) & (L - 1)) / (float)L;
      v = (q <= 16) ? __builtin_amdgcn_sinf(fr) : __builtin_amdgcn_cosf(fr);
    }
    z[pi * 34 + q] = v;
  }
  __syncthreads();
  {
    const int j = tid & 63, pg = tid >> 6;
    float a[4];
#pragma unroll
    for (int e = 0; e < 4; ++e) a[e] = p.in[IX_HB1][l * 64 + j];
    const float* w = p.in[IX_HW1] + (size_t)l * 33 * 64 + j;
    float wv1[33];
#pragma unroll
    for (int i = 0; i < 33; ++i) wv1[i] = w[i * 64];
#pragma unroll
    for (int i = 0; i < 33; ++i) {
#pragma unroll
      for (int e = 0; e < 4; ++e) a[e] += z[(pg * 4 + e) * 34 + i] * wv1[i];
    }
#pragma unroll
    for (int e = 0; e < 4; ++e) h1[(pg * 4 + e) * 64 + j] = __sinf(a[e]);
  }
  __syncthreads();
  {
    const int j = tid & 63, pg = tid >> 6;
    float a[4];
#pragma unroll
    for (int e = 0; e < 4; ++e) a[e] = p.in[IX_HB2][l * 64 + j];
    const float* w = p.in[IX_HW2] + (size_t)l * 64 * 64 + j;
#pragma unroll 1
    for (int i0 = 0; i0 < 64; i0 += 32) {
      float wv2[32];
#pragma unroll
      for (int i = 0; i < 32; ++i) wv2[i] = w[(i0 + i) * 64];
#pragma unroll
      for (int i = 0; i < 32; ++i) {
#pragma unroll
        for (int e = 0; e < 4; ++e) a[e] += h1[(pg * 4 + e) * 64 + i0 + i] * wv2[i];
      }
    }
#pragma unroll
    for (int e = 0; e < 4; ++e) h2[j * 16 + pg * 4 + e] = __sinf(a[e]);
  }
  __syncthreads();
  float* hf = (float*)(p.ws + WS_BIG + BG_HF) + ((size_t)l * 2304 + r0) * 1024;
  const float* w3 = p.in[IX_HW3] + (size_t)l * 64 * 1024;
#pragma unroll 1
  for (int q = 0; q < 4; ++q) {
    const int n = q * 256 + tid;
    float acc[16];
#pragma unroll
    for (int e = 0; e < 16; ++e) acc[e] = 0.f;
#pragma unroll 1
    for (int i0 = 0; i0 < 64; i0 += 32) {
      float wv[32];
#pragma unroll
      for (int e = 0; e < 32; ++e) wv[e] = w3[(i0 + e) * 1024 + n];
#pragma unroll
      for (int e = 0; e < 32; ++e) {
        const f32x4* hp = (const f32x4*)(h2 + (i0 + e) * 16);
#pragma unroll
        for (int g = 0; g < 4; ++g) {
          f32x4 hv = hp[g];
          acc[g * 4 + 0] += hv[0] * wv[e]; acc[g * 4 + 1] += hv[1] * wv[e];
          acc[g * 4 + 2] += hv[2] * wv[e]; acc[g * 4 + 3] += hv[3] * wv[e];
        }
      }
    }
    const int ch = n & 255;
    const float la = -3.0701134573253944f, lb = -15.350567286626972f;
    const float delta = fabsf(la + (lb - la) * ((float)ch / 255.f));
    float asum = 0.f;
    const bool bwd = (n & 256) != 0;
#pragma unroll
    for (int e = 0; e < 16; ++e) {
      const float tt = (float)(pos0 + e) / (float)L;
      const float v = acc[e] * __expf(-tt * delta);
      hf[(size_t)e * 1024 + n] = v;
      if (!(bwd && pos0 + e == 0)) asum += fabsf(v);
    }
    ((float*)(p.ws + WS_PS))[(size_t)job * 1024 + n] = asum;
  }
}

DEVI void hyfin_job(const Params& p, int job, char* smem) {
  float* red = (float*)smem;
  const int tid = otid();
  int l, cfg, o, cc, yc;
  if (job < 256) { cfg = 1; l = job >> 7; o = (job >> 6) & 1; cc = (job >> 3) & 7; yc = job & 7; }
  else { const int j = job - 256; cfg = 0; l = j >> 4; o = (j >> 3) & 1; cc = j & 7; yc = 0; }
  const int L = cfg ? 2048 : 256;
  const int ch = tid & 31, pg = tid >> 5;
  const int c = cc * 32 + ch;
  const float* hf = (const float*)(p.ws + WS_BIG + BG_HF) + ((size_t)l * 2304 + (cfg ? 0 : 2048)) * 1024 + o * 512 + c;
  const float* ps = (const float*)(p.ws + WS_PS) + ((size_t)l * 144 + (cfg ? 0 : 128)) * 1024 + o * 512 + c;
  const int njobs = cfg ? 128 : 16;
  __syncthreads();
  float s = 0.f;
#pragma unroll 8
  for (int j = pg; j < njobs; j += 8) s += ps[(size_t)j * 1024] + ps[(size_t)j * 1024 + 256];
  red[pg * 32 + ch] = s;
  __syncthreads();
  float tot = 0.f;
#pragma unroll
  for (int i = 0; i < 8; ++i) tot += red[i * 32 + ch];
  const float sc = 1.f / (tot + EPS);
  u16* g = (u16*)(p.ws + WS_GRV) + (size_t)l * GRV_PER_LAYER + (cfg ? 0 : 2097152) + ((size_t)o * 256 + c) * (2 * L);
  const int y0 = yc * 512;
#pragma unroll 8
  for (int k = 0; k < 64; ++k) {
    const int y = y0 + pg + 8 * k;
    const int d = L - y;
    float v;
    if (d == L) v = 0.f;
    else if (d >= 0) v = hf[(size_t)d * 1024] * sc;
    else v = hf[(size_t)(-d) * 1024 + 256] * sc;
    g[y] = f2bf(v);
  }
}

DEVI void cc_job(const Params& p, int job) {
  const int i0 = (job * 256 + otid()) * 8;
  const float* src = p.in[IX_CCKV] + i0;
  int b = i0 / (2 * 256 * 128), rem = i0 % (2 * 256 * 128);
  int l = rem / (256 * 128), rr = rem % (256 * 128);
  u16* dst = (u16*)(p.ws + WS_CC) + ((size_t)l * 2048 + b * 256) * 128 + rr;
  bf16x8 v;
#pragma unroll
  for (int e = 0; e < 8; ++e) v[e] = (short)f2bf(src[e]);
  *(bf16x8*)dst = v;
}

DEVI void rowop_job(const Params& p, int l, int mode, int job) {
  const int wid = otid() >> 6, lane = otid() & 63;
  const int row0 = job * 8 + wid * 2;
  const int isl = row0 >= MC;
  const int bi = isl ? 1 + ((row0 - MC) >> 11) : 0;
  const float* mod = (const float*)(p.ws + WS_MOD);
  const bool last = (mode == 2 && l == 1);
  const int ln = (mode == 2 && !last) ? l + 1 : l;
  const int nidx = (mode == 1) ? 2 : 0;
  const int moff = (mode == 1) ? 3072 : 0;
  const float* ng1 = p.in[IX_NORMG] + (size_t)(l * 4 + (mode == 1 ? 1 : 3)) * 1024;
  const float* gate = mod + ((size_t)l * 9 + bi) * 6144 + (mode == 1 ? 2048 : 5120);
  const float* ng2 = p.in[IX_NORMG] + (size_t)(ln * 4 + nidx) * 1024;
  const float* mm = mod + ((size_t)ln * 9 + bi) * 6144 + moff;
  float4 xv[2][4], gv[4], nv1[4], nv2[4], sh[4], sc[4];
  bf16x4 mraw[2][4];
#pragma unroll
  for (int r = 0; r < 2; ++r) {
    const int row = row0 + r;
    const float* xin;
    if (mode == 2 || l > 0) xin = p.out + (size_t)row * 1024;
    else xin = isl ? p.in[IX_XS] + (size_t)(row - MC) * 1024 : p.in[IX_XP] + (size_t)row * 1024;
#pragma unroll
    for (int q = 0; q < 4; ++q) {
      const f32x4 t = __builtin_nontemporal_load((const f32x4*)(xin + q * 256 + lane * 4));
      xv[r][q] = make_float4(t[0], t[1], t[2], t[3]);
    }
    if (mode != 0) {
      const u16* hb = (const u16*)(p.ws + WS_HB) + (size_t)row * 1024;
#pragma unroll
      for (int q = 0; q < 4; ++q) mraw[r][q] = *(const bf16x4*)(hb + q * 256 + lane * 4);
    }
  }
  if (mode != 0) {
#pragma unroll
    for (int q = 0; q < 4; ++q) {
      gv[q] = *(const float4*)(gate + q * 256 + lane * 4);
      nv1[q] = *(const float4*)(ng1 + q * 256 + lane * 4);
    }
  }
  if (!last) {
#pragma unroll
    for (int q = 0; q < 4; ++q) {
      nv2[q] = *(const float4*)(ng2 + q * 256 + lane * 4);
      sh[q] = *(const float4*)(mm + q * 256 + lane * 4);
      sc[q] = *(const float4*)(mm + 1024 + q * 256 + lane * 4);
    }
  }
#pragma unroll
  for (int r = 0; r < 2; ++r) {
    const int row = row0 + r;
    u16* hb = (u16*)(p.ws + WS_HB) + (size_t)row * 1024;
    float* X = p.out + (size_t)row * 1024;
    float x[16];
#pragma unroll
    for (int q = 0; q < 4; ++q) { x[q * 4 + 0] = xv[r][q].x; x[q * 4 + 1] = xv[r][q].y; x[q * 4 + 2] = xv[r][q].z; x[q * 4 + 3] = xv[r][q].w; }
    if (mode != 0) {
      float mv[16];
      float ss = 0.f;
#pragma unroll
      for (int q = 0; q < 4; ++q) {
#pragma unroll
        for (int e = 0; e < 4; ++e) { mv[q * 4 + e] = bfs(mraw[r][q][e]); ss += mv[q * 4 + e] * mv[q * 4 + e]; }
      }
#pragma unroll
      for (int s = 1; s < 64; s <<= 1) ss += __shfl_xor(ss, s);
      const float rs = rsqrtf(ss * (1.f / 1024.f) + EPS);
#pragma unroll
      for (int q = 0; q < 4; ++q) {
        x[q * 4 + 0] += gv[q].x * (mv[q * 4 + 0] * rs * nv1[q].x);
        x[q * 4 + 1] += gv[q].y * (mv[q * 4 + 1] * rs * nv1[q].y);
        x[q * 4 + 2] += gv[q].z * (mv[q * 4 + 2] * rs * nv1[q].z);
        x[q * 4 + 3] += gv[q].w * (mv[q * 4 + 3] * rs * nv1[q].w);
        __builtin_nontemporal_store((f32x4){x[q * 4 + 0], x[q * 4 + 1], x[q * 4 + 2], x[q * 4 + 3]}, (f32x4*)(X + q * 256 + lane * 4));
      }
    }
    if (!last) {
      float ss = 0.f;
#pragma unroll
      for (int e = 0; e < 16; ++e) ss += x[e] * x[e];
#pragma unroll
      for (int s = 1; s < 64; s <<= 1) ss += __shfl_xor(ss, s);
      const float rs = rsqrtf(ss * (1.f / 1024.f) + EPS);
#pragma unroll
      for (int q = 0; q < 4; ++q) {
        bf16x4 o = pack4(x[q * 4 + 0] * rs * nv2[q].x * (1.f + sc[q].x) + sh[q].x, x[q * 4 + 1] * rs * nv2[q].y * (1.f + sc[q].y) + sh[q].y,
                         x[q * 4 + 2] * rs * nv2[q].z * (1.f + sc[q].z) + sh[q].z, x[q * 4 + 3] * rs * nv2[q].w * (1.f + sc[q].w) + sh[q].w);
        __hip_atomic_store((unsigned long long*)(hb + q * 256 + lane * 4), __builtin_bit_cast(unsigned long long, o), __ATOMIC_RELAXED, __HIP_MEMORY_SCOPE_AGENT);
      }
    }
  }
}

DEVI void l1extra_job(const Params& p, int l, int job) {
  const int tid = otid();
  const int b = job >> 2, h = job & 3;
  u16* rk = (u16*)(p.ws + WS_BIG + BG_RKL) + ((size_t)job * 2176 + 2048) * 64;
  u16* rvt = (u16*)(p.ws + WS_BIG + BG_RVTL) + (size_t)job * 64 * 2176 + 2048;
  const float* st = p.in[IX_STATE] + (size_t)((b * 2 + l) * 2) * 4 * 4096;
  for (int i = tid; i < 128 * 64; i += 256) {
    int kk = i >> 6, d = i & 63;
    rk[i] = ((kk & 63) == d) ? (u16)0x3f80 : (u16)0;
    int e = i >> 7, vi = i & 127;
    int dir = vi >> 6, dk = vi & 63;
    rvt[(size_t)e * 2176 + vi] = f2bf(st[((size_t)(dir * 4 + h) * 64 + dk) * 64 + e]);
  }
  if (h == 0) {
    u16* kr = (u16*)(p.ws + WS_BIG + BG_KRAL) + ((size_t)b * 2304 + 2048) * 32;
    const float* src = p.in[IX_CKR] + (size_t)(b * 2 + l) * 256 * 32;
    for (int i = tid; i < 256 * 32; i += 256) kr[i] = f2bf(src[i]);
  }
}

enum { EPI_WIN = 0, EPI_MQ, EPI_MKV, EPI_MKVC, EPI_FOUR, EPI_WOUT, EPI_FFNUP, EPI_FFNDN };

template <int EPI, int MI>
DEVI void gemm_job(const Params& p, int l, const u16* __restrict__ A, int lda, const u16* __restrict__ Bt, int ldb,
                   int K, int mt, int nt, int aux, char* smem) {
  const int tid = otid(), wid = tid >> 6, lane = tid & 63;
  const int wr = wid >> 1, wc = wid & 1, fr = lane & 15, fq = lane >> 4;
  constexpr int TM = MI * 32;
  constexpr int SB = (TM + 128) * 64;
  constexpr int BOFF = TM * 64;
  constexpr int NST = (MI == 8) ? 3 : 4;
  constexpr int NLD = (MI + 1) / 2 + 2;
  const int wrow = wr * (MI * 16);
  float* sRS = (float*)(smem + 73728);
  const u16* Ab = A + (size_t)mt * TM * lda;
  const u16* Bb = Bt + (size_t)nt * 128 * ldb;
  __syncthreads();
  if (EPI == EPI_MKV && nt == 0 && mt * TM < MC)
#pragma unroll 1
  for (int rr_ = 0; rr_ < TM / 128; ++rr_) {
    const int r = rr_ * 128 + (tid >> 1), hf = tid & 1;
    const u16* rowp = Ab + (size_t)r * lda + hf * 64;
    bf16x8 v[8];
#pragma unroll
    for (int c = 0; c < 8; ++c) v[c] = *(const bf16x8*)(rowp + c * 8);
    float ss = 0.f;
#pragma unroll
    for (int c = 0; c < 8; ++c)
#pragma unroll
      for (int e = 0; e < 8; ++e) { float f = bfs(v[c][e]); ss += f * f; }
    ss += __shfl_xor(ss, 1);
    const float rs = rsqrtf(ss * (1.f / 128.f) + EPS);
    const int row = mt * TM + r;
    const int b = row >> 8, t = row & 255;
    float* o = p.out + OUT_CKV + ((size_t)(b * 2 + l) * 256 + t) * 128 + hf * 64;
    const float* g = p.in[IX_KVNORM] + l * 128 + hf * 64;
#pragma unroll
    for (int c = 0; c < 8; ++c) {
      float4 g0 = *(const float4*)(g + c * 8), g1 = *(const float4*)(g + c * 8 + 4);
      *(float4*)(o + c * 8) = make_float4(bfs(v[c][0]) * rs * g0.x, bfs(v[c][1]) * rs * g0.y, bfs(v[c][2]) * rs * g0.z, bfs(v[c][3]) * rs * g0.w);
      *(float4*)(o + c * 8 + 4) = make_float4(bfs(v[c][4]) * rs * g1.x, bfs(v[c][5]) * rs * g1.y, bfs(v[c][6]) * rs * g1.z, bfs(v[c][7]) * rs * g1.w);
    }
    asm volatile("s_waitcnt vmcnt(0)" ::: "memory");
  }
  float rss = 0.f;
  const int rsoff = (MI == 8 ? tid : (tid >> 1)) * 64;
  const int rsc0 = (MI == 8) ? 0 : (((tid & 1) * 2) ^ ((0 - (tid >> 3)) & 3)) * 16;
  const int rsc1 = (MI == 8) ? 16 : (((tid & 1) * 2 + 1) ^ ((0 - (tid >> 3)) & 3)) * 16;
  const int srow = tid >> 2;
  const int scol = ((tid & 3) ^ ((0 - (srow >> 2)) & 3)) * 8;
  const u16* ga = Ab + (size_t)srow * lda + scol;
  const u16* gb = Bb + (size_t)srow * ldb + scol;
  auto stage_a = [&](int kt, int buf) {
    char* d = smem + buf * SB + tid * 16;
#pragma unroll
    for (int i = 0; i < (MI + 1) / 2; ++i) glds16(ga + (size_t)(64 * i) * lda + kt * 32, d + i * 4096);
  };
  auto stage_b = [&](int kt, int buf) {
    char* d = smem + buf * SB + tid * 16;
#pragma unroll
    for (int i = 0; i < 2; ++i) glds16(gb + (size_t)(64 * i) * ldb + kt * 32, d + BOFF + i * 4096);
  };
  auto stage = [&](int kt, int buf) { stage_a(kt, buf); stage_b(kt, buf); };
  f32x4 acc[MI][4];
  const int nk = K >> 5;
#pragma unroll 1
  for (int rep_ = 0; rep_ < ((PROBE_G == 1 && EPI == EPI_MKV) ? 2 : 1); ++rep_) {
  if (rep_) { asm volatile("s_waitcnt vmcnt(0) lgkmcnt(0)" ::: "memory"); __syncthreads(); rss = 0.f; }
#pragma unroll
  for (int m = 0; m < MI; ++m)
#pragma unroll
    for (int n = 0; n < 4; ++n) acc[m][n] = (f32x4){0.f, 0.f, 0.f, 0.f};
  const int sw = (fq ^ ((0 - (fr >> 2)) & 3)) * 16;
  const int aoff = (wrow + fr) * 64 + sw, boff = BOFF + (wc * 64 + fr) * 64 + sw;
#pragma unroll
  for (int s = 0; s < NST - 1; ++s)
    if (s < nk) stage(s, s);
  int cb = 0, nb2 = NST - 1;
#pragma unroll 1
  for (int kt = 0; kt < nk; ++kt) {
    const int ahead = nk - 1 - kt;
    if (NST == 4) {
      if (ahead >= 2) wait_vm<2 * NLD>();
      else if (ahead == 1) wait_vm<NLD>();
      else wait_vm<0>();
    } else {
      if (ahead >= 1) wait_vm<NLD>();
      else wait_vm<0>();
    }
    __builtin_amdgcn_s_barrier();
    const bool more = kt + NST - 1 < nk;
    const char* base = smem + cb * SB;
    if (EPI == EPI_MQ || EPI == EPI_MKV) {
      bf16x8 x0 = *(const bf16x8*)(base + rsoff + rsc0), x1 = *(const bf16x8*)(base + rsoff + rsc1);
#pragma unroll
      for (int e = 0; e < 8; ++e) { float f0 = bfs(x0[e]), f1 = bfs(x1[e]); rss += f0 * f0 + f1 * f1; }
      if (MI == 8) {
        bf16x8 x2 = *(const bf16x8*)(base + rsoff + 32), x3 = *(const bf16x8*)(base + rsoff + 48);
#pragma unroll
        for (int e = 0; e < 8; ++e) { float f0 = bfs(x2[e]), f1 = bfs(x3[e]); rss += f0 * f0 + f1 * f1; }
      }
    }
    bf16x8 af[MI], bfv[4];
    constexpr int H1 = MI / 2;
#pragma unroll
    for (int m = 0; m < H1; ++m) af[m] = *(const bf16x8*)(base + aoff + m * 1024);
#pragma unroll
    for (int n = 0; n < 4; ++n) bfv[n] = *(const bf16x8*)(base + boff + n * 1024);
    __builtin_amdgcn_sched_barrier(0);
#pragma unroll
    for (int m = 0; m < H1 / 2; ++m)
#pragma unroll
      for (int n = 0; n < 4; ++n) acc[m][n] = __builtin_amdgcn_mfma_f32_16x16x32_bf16(af[m], bfv[n], acc[m][n], 0, 0, 0);
    __builtin_amdgcn_sched_barrier(0);
#pragma unroll
    for (int m = H1; m < MI; ++m) af[m] = *(const bf16x8*)(base + aoff + m * 1024);
    if (more) stage_a(kt + NST - 1, nb2);
    __builtin_amdgcn_sched_barrier(0);
#pragma unroll
    for (int m = H1 / 2; m < H1; ++m)
#pragma unroll
      for (int n = 0; n < 4; ++n) acc[m][n] = __builtin_amdgcn_mfma_f32_16x16x32_bf16(af[m], bfv[n], acc[m][n], 0, 0, 0);
    __builtin_amdgcn_sched_barrier(0);
    if (more) stage_b(kt + NST - 1, nb2);
    __builtin_amdgcn_sched_barrier(0);
#pragma unroll
    for (int m = H1; m < MI; ++m)
#pragma unroll
      for (int n = 0; n < 4; ++n) acc[m][n] = __builtin_amdgcn_mfma_f32_16x16x32_bf16(af[m], bfv[n], acc[m][n], 0, 0, 0);
    cb = (cb + 1 == NST) ? 0 : cb + 1;
    nb2 = (nb2 + 1 == NST) ? 0 : nb2 + 1;
  }
  }
  if (EPI == EPI_MQ || EPI == EPI_MKV) {
    if (MI == 8) {
      sRS[tid] = rsqrtf(rss / (float)K + EPS);
    } else {
      rss += __shfl_xor(rss, 1);
      if ((tid & 1) == 0) sRS[tid >> 1] = rsqrtf(rss / (float)K + EPS);
    }
    __syncthreads();
  }
  const int r0 = mt * TM;
#pragma unroll 1
  for (int rep2_ = 0; rep2_ < ((PROBE_G == 2 && EPI == EPI_MKV) ? 2 : 1); ++rep2_)
  if (EPI == EPI_WIN) {
    const int isl = r0 >= MC;
    const int b = isl ? (r0 - MC) >> 11 : r0 >> 8;
    const int tb = isl ? (r0 - MC) & 2047 : r0 & 255;
    const int L = isl ? 2048 : 256;
    char* big = p.ws + WS_BIG;
    if (nt < 4) {
      const int head = (nt & 1) * 2 + wc;
      const bool isk = nt >= 2;
      u16* dst;
      if (!isk) dst = (u16*)(big + BG_RQ) + (isl ? (size_t)MC * 256 + (size_t)(b * 4 + head) * 2048 * 64 : (size_t)(b * 4 + head) * 256 * 64);
      else dst = isl ? (u16*)(big + BG_RKL) + (size_t)(b * 4 + head) * 2176 * 64 : (u16*)(big + BG_RKC) + (size_t)(b * 4 + head) * 256 * 64;
      const float inv = ex2(-(float)fr * (LOG2_1E4 / 16.f));
#pragma unroll
      for (int m = 0; m < MI; ++m)
#pragma unroll
        for (int j = 0; j < 4; ++j) {
          const int t = tb + wrow + m * 16 + fq * 4 + j;
          float o0 = acc[m][0][j], o1 = acc[m][1][j], o2 = acc[m][2][j], o3 = acc[m][3][j];
          if (isl) {
            float ar = (float)(t >> 6) * inv, ac = (float)(t & 63) * inv;
            float cr = __cosf(ar), sr = __sinf(ar), cc = __cosf(ac), sc = __sinf(ac);
            float n0 = o0 * cr - o1 * sr, n1 = o1 * cr + o0 * sr, n2 = o2 * cc - o3 * sc, n3 = o3 * cc + o2 * sc;
            o0 = n0; o1 = n1; o2 = n2; o3 = n3;
          }
          u16* d = dst + (size_t)t * 64 + fr;
          d[0] = f2bf(o0); d[16] = f2bf(o1); d[32] = f2bf(o2); d[48] = f2bf(o3);
        }
    } else if (nt < 6) {
      const int head = (nt & 1) * 2 + wc;
      const int Lk = isl ? 2176 : 256;
      u16* dst = isl ? (u16*)(big + BG_RVTL) + (size_t)(b * 4 + head) * 64 * 2176 : (u16*)(big + BG_RVTC) + (size_t)(b * 4 + head) * 64 * 256;
#pragma unroll
      for (int m = 0; m < MI; ++m)
#pragma unroll
        for (int n = 0; n < 4; ++n) {
          const int t = tb + wrow + m * 16 + fq * 4;
          *(bf16x4*)(dst + (size_t)(n * 16 + fr) * Lk + t) = pack4(acc[m][n][0], acc[m][n][1], acc[m][n][2], acc[m][n][3]);
        }
    } else if (nt < 8 || nt == 12 || nt == 13 || nt == 20) {
      u16* dst;
      int ld, c0;
      if (nt < 8) { dst = (u16*)(big + BG_RG); ld = 256; c0 = (nt - 6) * 128; }
      else if (nt < 14) { dst = (u16*)(big + BG_CQ); ld = 256; c0 = (nt - 12) * 128; }
      else { dst = (u16*)(big + BG_CKV); ld = 128; c0 = 0; }
#pragma unroll
      for (int m = 0; m < MI; ++m)
#pragma unroll
        for (int n = 0; n < 4; ++n)
#pragma unroll
          for (int j = 0; j < 4; ++j) {
            float v = acc[m][n][j];
            if (nt < 8) v = siluf(v);
            dst[(size_t)(r0 + wrow + m * 16 + fq * 4 + j) * ld + c0 + wc * 64 + n * 16 + fr] = f2bf(v);
          }
    } else if (nt < 12) {
      const int half = nt >= 10;
      u16* dst = (u16*)(big + BG_XCS) + (isl ? (size_t)MC * 512 + (size_t)b * 256 * 4096 : (size_t)b * 256 * 512);
#pragma unroll
      for (int m = 0; m < MI; ++m)
#pragma unroll
        for (int n = 0; n < 4; ++n) {
          const int ch = (nt & 1) * 128 + wc * 64 + n * 16 + fr;
          const int t = tb + wrow + m * 16 + fq * 4;
          *(bf16x4*)(dst + (size_t)ch * (2 * L) + half * L + t) = pack4(acc[m][n][0], acc[m][n][1], acc[m][n][2], acc[m][n][3]);
        }
    } else if (nt < 20) {
      u16* dst = (u16*)(big + BG_HUT) + (isl ? (size_t)MC * 768 + (size_t)b * 768 * 2048 : (size_t)b * 768 * 256);
#pragma unroll
      for (int m = 0; m < MI; ++m)
#pragma unroll
        for (int n = 0; n < 4; ++n) {
          const int ch = (nt - 14) * 128 + wc * 64 + n * 16 + fr;
          const int t = tb + wrow + m * 16 + fq * 4;
          *(bf16x4*)(dst + (size_t)ch * L + t) = pack4(acc[m][n][0], acc[m][n][1], acc[m][n][2], acc[m][n][3]);
        }
    } else {
      if (wc == 0) {
        const float inv = ex2(-(float)(fr & 7) * (LOG2_1E4 / 8.f));
#pragma unroll
        for (int m = 0; m < MI; ++m)
#pragma unroll
          for (int n = 0; n < 2; ++n)
#pragma unroll
            for (int j = 0; j < 4; ++j) {
              const int t = tb + wrow + m * 16 + fq * 4 + j;
              const int d = n * 16 + fr;
              float v = acc[m][n][j];
              float pr = __shfl_xor(v, 8);
              if (!isl) {
                p.out[OUT_KR + ((size_t)(b * 2 + l) * 256 + t) * 32 + d] = v;
                ((u16*)(big + BG_KRAC))[((size_t)b * 256 + t) * 32 + d] = f2bf(v);
              } else {
                float ang = (float)(n == 0 ? (t >> 6) : (t & 63)) * inv;
                float cs = __cosf(ang), sn = __sinf(ang);
                float o = (fr & 8) ? (v * cs + pr * sn) : (v * cs - pr * sn);
                ((u16*)(big + BG_KRAL))[((size_t)b * 2304 + t) * 32 + d] = f2bf(o);
              }
            }
      }
    }
  } else if (EPI == EPI_MQ) {
    const int isl = r0 >= MC;
    const int b = isl ? (r0 - MC) >> 11 : r0 >> 8;
    const int tb = isl ? (r0 - MC) & 2047 : r0 & 255;
    const int L = isl ? 2048 : 256;
    u16* dst = (u16*)(p.ws + WS_HB + HB_MQ) + (isl ? (size_t)MC * 384 : 0);
    const float inv = ex2(-(float)(fr & 7) * (LOG2_1E4 / 8.f));
#pragma unroll
    for (int n = 0; n < 4; ++n) {
      const int c0 = nt * 128 + wc * 64 + n * 16;
      const int head = c0 / 96, d0 = c0 % 96;
#pragma unroll
      for (int m = 0; m < MI; ++m)
#pragma unroll
        for (int j = 0; j < 4; ++j) {
          const int lr = wrow + m * 16 + fq * 4 + j;
          const int t = tb + lr;
          float v = acc[m][n][j] * sRS[lr];
          if (isl && d0 >= 64) {
            float pr = __shfl_xor(v, 8);
            float ang = (float)(d0 == 64 ? (t >> 6) : (t & 63)) * inv;
            float cs = __cosf(ang), sn = __sinf(ang);
            v = (fr & 8) ? (v * cs + pr * sn) : (v * cs - pr * sn);
          }
          dst[((size_t)(b * 4 + head) * L + t) * 96 + d0 + fr] = f2bf(v);
        }
    }
  } else if (EPI == EPI_MKV || EPI == EPI_MKVC) {
    int isl, b, tk, Lk;
    if (EPI == EPI_MKV) {
      isl = r0 >= MC;
      b = isl ? (r0 - MC) >> 11 : r0 >> 8;
      tk = isl ? (r0 - MC) & 2047 : r0 & 255;
    } else {
      isl = 1; b = mt >> 1; tk = 2048 + (mt & 1) * 128;
    }
    Lk = isl ? 2304 : 256;
    const int h = nt;
    if (wc == 0) {
      u16* dst = (u16*)(p.ws + WS_HB + (isl ? HB_MKNL : HB_MKNC)) + (size_t)(b * 4 + h) * Lk * 64;
#pragma unroll
      for (int m = 0; m < MI; ++m)
#pragma unroll
        for (int n = 0; n < 4; ++n)
#pragma unroll
          for (int j = 0; j < 4; ++j) {
            const int lr = wrow + m * 16 + fq * 4 + j;
            float v = acc[m][n][j];
            if (EPI == EPI_MKV) v *= sRS[lr];
            dst[(size_t)(tk + lr) * 64 + n * 16 + fr] = f2bf(v);
          }
    } else {
      u16* dst = (u16*)(p.ws + WS_HB + (isl ? HB_MVTL : HB_MVTC)) + (size_t)(b * 4 + h) * 64 * Lk;
#pragma unroll
      for (int m = 0; m < MI; ++m)
#pragma unroll
        for (int n = 0; n < 4; ++n) {
          const int lr = wrow + m * 16 + fq * 4;
          float s0 = 1.f, s1 = 1.f, s2 = 1.f, s3 = 1.f;
          if (EPI == EPI_MKV) { s0 = sRS[lr]; s1 = sRS[lr + 1]; s2 = sRS[lr + 2]; s3 = sRS[lr + 3]; }
          *(bf16x4*)(dst + (size_t)(n * 16 + fr) * Lk + tk + lr) =
              pack4(acc[m][n][0] * s0, acc[m][n][1] * s1, acc[m][n][2] * s2, acc[m][n][3] * s3);
        }
    }
  } else if (EPI == EPI_FOUR) {
    u16* dst = (u16*)(p.ws + WS_BIG + BG_CONCAT);
#pragma unroll
    for (int m = 0; m < MI; ++m)
#pragma unroll
      for (int n = 0; n < 4; ++n)
#pragma unroll
        for (int j = 0; j < 4; ++j)
          dst[(size_t)(aux + r0 + wrow + m * 16 + fq * 4 + j) * 1024 + 256 + nt * 128 + wc * 64 + n * 16 + fr] = f2bf(acc[m][n][j]);
  } else if (EPI == EPI_WOUT || EPI == EPI_FFNDN) {
    u16* dst = (u16*)(p.ws + WS_HB);
#pragma unroll
    for (int m = 0; m < MI; ++m)
#pragma unroll
      for (int n = 0; n < 4; ++n)
#pragma unroll
        for (int j = 0; j < 4; ++j)
          dst[(size_t)(r0 + wrow + m * 16 + fq * 4 + j) * 1024 + nt * 128 + wc * 64 + n * 16 + fr] = f2bf(acc[m][n][j]);
  } else if (EPI == EPI_FFNUP) {
    u16* dst = (u16*)(p.ws + WS_BIG + BG_ACT);
#pragma unroll
    for (int m = 0; m < MI; ++m)
#pragma unroll
      for (int n = 0; n < 4; n += 2)
#pragma unroll
        for (int j = 0; j < 4; ++j) {
          float g = acc[m][n][j], u = acc[m][n + 1][j];
          dst[(size_t)(r0 + wrow + m * 16 + fq * 4 + j) * 2816 + nt * 64 + wc * 32 + (n >> 1) * 16 + fr] = f2bf(siluf(g) * u);
        }
  }
}

template <int MODE>
DEVI void attn_job(const Params& p, int l, int job, char* smem) {
  constexpr int DQK = MODE == 0 ? 96 : 64;
  constexpr int KS = DQK / 32;
  constexpr int KSTR = DQK + 8;
  constexpr int KCH = DQK / 8;
  constexpr int NKL = (64 * KCH) / 256;
  const int tid = otid(), wid = tid >> 6, lane = tid & 63, fr = lane & 15, fq = lane >> 4;
  int isl, b, h, qt;
  if (job < 512) { isl = 1; const int bhj = job & 31; b = bhj >> 2; h = bhj & 3; qt = job >> 5; }
  else { int j = job - 512; isl = 0; const int bhj = j & 63; b = bhj >> 2; h = bhj & 3; qt = j >> 6; }
  const int L = isl ? 2048 : 256;
  const int Lk = MODE == 0 ? (isl ? 2304 : 256) : (isl ? 2176 : 256);
  const int bh = b * 4 + h;
  const u16 *Q, *Kn, *Kr = nullptr, *Vt;
  if (MODE == 0) {
    Q = (const u16*)(p.ws + WS_HB + HB_MQ) + (isl ? (size_t)MC * 384 : 0) + (size_t)bh * L * 96;
    Kn = (const u16*)(p.ws + WS_HB + (isl ? HB_MKNL : HB_MKNC)) + (size_t)bh * Lk * 64;
    Kr = (const u16*)(p.ws + WS_BIG + (isl ? BG_KRAL : BG_KRAC)) + (size_t)b * Lk * 32;
    Vt = (const u16*)(p.ws + WS_HB + (isl ? HB_MVTL : HB_MVTC)) + (size_t)bh * 64 * Lk;
  } else {
    Q = (const u16*)(p.ws + WS_BIG + BG_RQ) + (isl ? (size_t)MC * 256 : 0) + (size_t)bh * L * 64;
    Kn = (const u16*)(p.ws + WS_BIG + (isl ? BG_RKL : BG_RKC)) + (size_t)bh * Lk * 64;
    Vt = (const u16*)(p.ws + WS_BIG + (isl ? BG_RVTL : BG_RVTC)) + (size_t)bh * 64 * Lk;
  }
  u16* sK = (u16*)smem;
  u16* sV = sK + 64 * KSTR;
  const int q0 = qt * 128 + wid * 32;
  bf16x8 qf[2][KS];
#pragma unroll
  for (int nb = 0; nb < 2; ++nb)
#pragma unroll
    for (int ks = 0; ks < KS; ++ks) qf[nb][ks] = *(const bf16x8*)(Q + (size_t)(q0 + nb * 16 + fr) * DQK + ks * 32 + fq * 8);
  f32x4 o[4][2];
#pragma unroll
  for (int eb = 0; eb < 4; ++eb)
#pragma unroll
    for (int nb = 0; nb < 2; ++nb) o[eb][nb] = (f32x4){0.f, 0.f, 0.f, 0.f};
  float mrun[2] = {-1e30f, -1e30f}, lsum[2] = {0.f, 0.f};
  float lgf = 0.f, lgb = 0.f;
  if (MODE == 1) {
    float df = p.in[IX_DECAY][(l * 2 + 0) * 4 + h], db = p.in[IX_DECAY][(l * 2 + 1) * 4 + h];
    lgf = -__log2f(1.f + __expf(-df));
    lgb = -__log2f(1.f + __expf(-db));
  }
  float colf[4][4], colb[4][4];
  if (MODE == 1) {
#pragma unroll
    for (int mb = 0; mb < 4; ++mb)
#pragma unroll
      for (int j = 0; j < 4; ++j) {
        const int idx = mb * 16 + fq * 4 + j;
        colf[mb][j] = ex2((float)(63 - idx) * lgf);
        colb[mb][j] = ex2((float)idx * lgb);
      }
  }
  const int ntile = Lk >> 6;
  const u16* kp[NKL];
  int kstep[NKL], ko[NKL];
  const u16* vp[2];
  int vo[2];
#pragma unroll
  for (int i = 0; i < NKL; ++i) {
    const int cid = tid + 256 * i;
    const int row = cid / KCH, cc = cid % KCH;
    ko[i] = row * KSTR + cc * 8;
    if (MODE == 0 && cc >= 8) { kp[i] = Kr + (size_t)row * 32 + (cc - 8) * 8; kstep[i] = 64 * 32; }
    else { kp[i] = Kn + (size_t)row * 64 + cc * 8; kstep[i] = 64 * 64; }
  }
#pragma unroll
  for (int i = 0; i < 2; ++i) {
    const int cid = tid + 256 * i;
    const int e = cid >> 3, cc = cid & 7;
    vo[i] = e * 72 + cc * 8;
    vp[i] = Vt + (size_t)e * Lk + cc * 8;
  }
  bf16x8 kregs[2][NKL], vregs[2][2];
  auto gload = [&](const int set) {
#pragma unroll
    for (int i = 0; i < NKL; ++i) { kregs[set][i] = *(const bf16x8*)kp[i]; kp[i] += kstep[i]; }
#pragma unroll
    for (int i = 0; i < 2; ++i) { vregs[set][i] = *(const bf16x8*)vp[i]; vp[i] += 64; }
  };
#pragma unroll 1
  for (int rep_ = 0; rep_ < (PROBE_ATT ? 2 : 1); ++rep_) {
  if (rep_) {
#pragma unroll
    for (int i = 0; i < NKL; ++i) kp[i] -= (size_t)kstep[i] * ntile;
#pragma unroll
    for (int i = 0; i < 2; ++i) vp[i] -= (size_t)64 * ntile;
  }
  gload(0);
  gload(1);
#pragma unroll 1
  for (int kt2 = 0; kt2 < ntile; kt2 += 2) {
#pragma unroll
  for (int hh = 0; hh < 2; ++hh) {
    const int kt = kt2 + hh;
    __syncthreads();
#pragma unroll
    for (int i = 0; i < NKL; ++i) *(bf16x8*)(sK + ko[i]) = kregs[hh][i];
#pragma unroll
    for (int i = 0; i < 2; ++i) *(bf16x8*)(sV + vo[i]) = vregs[hh][i];
    __syncthreads();
    if (kt + 2 < ntile) gload(hh);
    f32x4 s[4][2];
#pragma unroll
    for (int mb = 0; mb < 4; ++mb)
#pragma unroll
      for (int nb = 0; nb < 2; ++nb) s[mb][nb] = (f32x4){0.f, 0.f, 0.f, 0.f};
#pragma unroll
    for (int ks = 0; ks < KS; ++ks)
#pragma unroll
      for (int mb = 0; mb < 4; ++mb) {
        bf16x8 kf = *(const bf16x8*)(sK + (mb * 16 + fr) * KSTR + ks * 32 + fq * 8);
#pragma unroll
        for (int nb = 0; nb < 2; ++nb) s[mb][nb] = __builtin_amdgcn_mfma_f32_16x16x32_bf16(kf, qf[nb][ks], s[mb][nb], 0, 0, 0);
      }
    if (MODE == 0) {
#pragma unroll
      for (int nb = 0; nb < 2; ++nb) {
        float mx = -1e30f;
#pragma unroll
        for (int mb = 0; mb < 4; ++mb)
#pragma unroll
          for (int j = 0; j < 4; ++j) mx = fmaxf(mx, s[mb][nb][j]);
        mx = fmaxf(mx, __shfl_xor(mx, 16));
        mx = fmaxf(mx, __shfl_xor(mx, 32));
        if (!__all(mx - mrun[nb] <= 6.f)) {
          const float mn = fmaxf(mrun[nb], mx);
          const float alpha = ex2(mrun[nb] - mn);
          mrun[nb] = mn;
          lsum[nb] *= alpha;
#pragma unroll
          for (int eb = 0; eb < 4; ++eb) o[eb][nb] *= alpha;
        }
        const float mn = mrun[nb];
        float ps = 0.f;
#pragma unroll
        for (int mb = 0; mb < 4; ++mb)
#pragma unroll
          for (int j = 0; j < 4; ++j) { float pv = ex2(s[mb][nb][j] - mn); s[mb][nb][j] = pv; ps += pv; }
        lsum[nb] += ps;
      }
    } else {
#pragma unroll
      for (int nb = 0; nb < 2; ++nb) {
        const int tq = q0 + nb * 16 + fr;
        const int kbase = kt * 64;
        if (kbase + 63 < q0) {
          const float rowf = ex2((float)(tq - kbase - 63) * lgf);
#pragma unroll
          for (int mb = 0; mb < 4; ++mb)
#pragma unroll
            for (int j = 0; j < 4; ++j) s[mb][nb][j] *= rowf * colf[mb][j];
        } else if (kbase < L && kbase > q0 + 31) {
          const float rowb = ex2((float)(kbase - tq) * lgb);
#pragma unroll
          for (int mb = 0; mb < 4; ++mb)
#pragma unroll
            for (int j = 0; j < 4; ++j) s[mb][nb][j] *= rowb * colb[mb][j];
        } else if (kbase < L) {
#pragma unroll
          for (int mb = 0; mb < 4; ++mb)
#pragma unroll
            for (int j = 0; j < 4; ++j) {
              const int sk = kt * 64 + mb * 16 + fq * 4 + j;
              const int diff = tq - sk;
              float e = diff >= 0 ? (float)diff * lgf : (float)(-diff) * lgb;
              float dm = ex2(e);
              if (diff == 0) dm = 2.f;
              s[mb][nb][j] *= dm;
            }
        } else {
          const float dm = (kt * 64 == L) ? ex2((float)(tq + 1) * lgf) : ex2((float)(L - tq) * lgb);
#pragma unroll
          for (int mb = 0; mb < 4; ++mb)
#pragma unroll
            for (int j = 0; j < 4; ++j) s[mb][nb][j] *= dm;
        }
      }
    }
#pragma unroll
    for (int s2 = 0; s2 < 2; ++s2) {
      bf16x8 pf[2];
#pragma unroll
      for (int nb = 0; nb < 2; ++nb) {
        u32x4 pw;
        pw[0] = pk2(s[2 * s2][nb][0], s[2 * s2][nb][1]);
        pw[1] = pk2(s[2 * s2][nb][2], s[2 * s2][nb][3]);
        pw[2] = pk2(s[2 * s2 + 1][nb][0], s[2 * s2 + 1][nb][1]);
        pw[3] = pk2(s[2 * s2 + 1][nb][2], s[2 * s2 + 1][nb][3]);
        pf[nb] = __builtin_bit_cast(bf16x8, pw);
      }
#pragma unroll
      for (int eb = 0; eb < 4; ++eb) {
        const u16* vp = sV + (eb * 16 + fr) * 72 + s2 * 32 + fq * 4;
        bf16x4 lo = *(const bf16x4*)vp;
        bf16x4 hi = *(const bf16x4*)(vp + 16);
        bf16x8 vf;
        vf[0] = lo[0]; vf[1] = lo[1]; vf[2] = lo[2]; vf[3] = lo[3];
        vf[4] = hi[0]; vf[5] = hi[1]; vf[6] = hi[2]; vf[7] = hi[3];
#pragma unroll
        for (int nb = 0; nb < 2; ++nb) o[eb][nb] = __builtin_amdgcn_mfma_f32_16x16x32_bf16(vf, pf[nb], o[eb][nb], 0, 0, 0);
      }
    }
  }
  }
  }
  u16* cat = (u16*)(p.ws + WS_BIG + BG_CONCAT);
#pragma unroll
  for (int nb = 0; nb < 2; ++nb) {
    const int row = row_base(isl, b) + q0 + nb * 16 + fr;
    if (MODE == 0) {
      float ls = lsum[nb];
      ls += __shfl_xor(ls, 16);
      ls += __shfl_xor(ls, 32);
      const float inv = 1.f / ls;
#pragma unroll
      for (int eb = 0; eb < 4; ++eb)
        *(bf16x4*)(cat + (size_t)row * 1024 + 512 + h * 64 + eb * 16 + fq * 4) =
            pack4(o[eb][nb][0] * inv, o[eb][nb][1] * inv, o[eb][nb][2] * inv, o[eb][nb][3] * inv);
    } else {
      float sm = 0.f;
#pragma unroll
      for (int eb = 0; eb < 4; ++eb)
#pragma unroll
        for (int j = 0; j < 4; ++j) sm += o[eb][nb][j];
      sm += __shfl_xor(sm, 16);
      sm += __shfl_xor(sm, 32);
      const float mu = sm * (1.f / 64.f);
      float vr = 0.f;
#pragma unroll
      for (int eb = 0; eb < 4; ++eb)
#pragma unroll
        for (int j = 0; j < 4; ++j) { float d = o[eb][nb][j] - mu; vr += d * d; }
      vr += __shfl_xor(vr, 16);
      vr += __shfl_xor(vr, 32);
      const float rs = rsqrtf(vr * (1.f / 64.f) + EPS);
      const u16* rg = (const u16*)(p.ws + WS_BIG + BG_RG) + (size_t)row * 256 + h * 64;
#pragma unroll
      for (int eb = 0; eb < 4; ++eb) {
        bf16x4 g = *(const bf16x4*)(rg + eb * 16 + fq * 4);
        *(bf16x4*)(cat + (size_t)row * 1024 + h * 64 + eb * 16 + fq * 4) =
            pack4((o[eb][nb][0] - mu) * rs * bfs(g[0]), (o[eb][nb][1] - mu) * rs * bfs(g[1]),
                  (o[eb][nb][2] - mu) * rs * bfs(g[2]), (o[eb][nb][3] - mu) * rs * bfs(g[3]));
      }
    }
  }
}

DEVI void state_job(const Params& p, int l, int job, char* smem) {
  u16* sK = (u16*)smem;
  u16* sV = sK + 128 * 64;
  float* sW = (float*)(sV + 64 * 136);
  const int tid = otid();
  const int b = job >> 3, h = (job >> 1) & 3, dir = job & 1;
  const int bh = b * 4 + h;
  const u16* K = (const u16*)(p.ws + WS_BIG + BG_RKC) + (size_t)bh * 256 * 64;
  const u16* Vt = (const u16*)(p.ws + WS_BIG + BG_RVTC) + (size_t)bh * 64 * 256;
  const float dd = p.in[IX_DECAY][(l * 2 + dir) * 4 + h];
  const float lg = -__log2f(1.f + __expf(-dd));
  const int dk = tid >> 2, eg = tid & 3;
  float acc[16];
#pragma unroll
  for (int i = 0; i < 16; ++i) acc[i] = 0.f;
  __syncthreads();
  sW[tid] = ex2((float)(dir == 0 ? 255 - tid : tid) * lg);
  for (int hf = 0; hf < 2; ++hf) {
    __syncthreads();
    {
      bf16x8 tk[4], tv[4];
#pragma unroll
      for (int q = 0; q < 4; ++q) {
        const int i = tid + 256 * q;
        tk[q] = *(const bf16x8*)(K + (size_t)(hf * 128 + (i >> 3)) * 64 + (i & 7) * 8);
        tv[q] = *(const bf16x8*)(Vt + (size_t)(i >> 4) * 256 + hf * 128 + (i & 15) * 8);
      }
#pragma unroll
      for (int q = 0; q < 4; ++q) {
        const int i = tid + 256 * q;
        *(bf16x8*)(sK + (i >> 3) * 64 + (i & 7) * 8) = tk[q];
        *(bf16x8*)(sV + (i >> 4) * 136 + (i & 15) * 8) = tv[q];
      }
    }
    __syncthreads();
    for (int s8 = 0; s8 < 128; s8 += 8) {
      float kw[8];
#pragma unroll
      for (int e = 0; e < 8; ++e) kw[e] = bf2f(sK[(s8 + e) * 64 + dk]) * sW[hf * 128 + s8 + e];
#pragma unroll
      for (int i = 0; i < 16; ++i) {
        bf16x8 v = *(const bf16x8*)(sV + (eg * 16 + i) * 136 + s8);
#pragma unroll
        for (int e = 0; e < 8; ++e) acc[i] += kw[e] * bfs(v[e]);
      }
    }
  }
  float* o = p.out + OUT_ST + ((((size_t)(b * 2 + l) * 2 + dir) * 4 + h) * 64 + dk) * 64 + eg * 16;
#pragma unroll
  for (int i = 0; i < 16; i += 4) *(float4*)(o + i) = make_float4(acc[i], acc[i + 1], acc[i + 2], acc[i + 3]);
}

template <int CFG>
DEVI void hyena_job(const Params& p, int l, int order, int job, char* smem) {
  constexpr int L = CFG ? 2048 : 256, NB = CFG ? 8 : 16, RSTR = CFG ? 2304 : 512, NG = CFG ? 8 : 4, GSTEP = CFG ? 32 : 16;
  constexpr int NCH = CFG ? 6 : 1;
  const int tid = otid(), wid = tid >> 6, lane = tid & 63, fr = lane & 15, fq = lane >> 4;
  int c, T0;
  if (CFG) { c = job >> 1; T0 = (job & 1) * 1024; } else { c = job; T0 = 0; }
  u16* sU = (u16*)smem;
  u16* sF = sU + NB * RSTR;
  const u16* HUT = (const u16*)(p.ws + WS_BIG + BG_HUT) + (CFG ? (size_t)MC * 768 : 0);
  u16* Z1 = (u16*)(p.ws + WS_Z1) + (CFG ? (size_t)MC * 256 : 0);
  const u16* GR = (const u16*)(p.ws + WS_GRV) + (size_t)l * GRV_PER_LAYER + (CFG ? 0 : 2097152) + ((size_t)order * 256 + c) * (2 * L);
  auto ub = [&](int bi) { return bi * RSTR + (CFG ? 32 * (bi & 3) : 8 * bi) + 64; };
  bf16x8 clo = (bf16x8){0, 0, 0, 0, 0, 0, 0, 0}, chi = (bf16x8){0, 0, 0, 0, 0, 0, 0, 0};
  auto gl_chunk = [&](int ch) {
    if (tid < 67) {
      const int yb = CFG ? (3568 - T0 - 512 * ch) : -16;
      const int y8 = yb + 8 * tid;
      clo = (bf16x8){0, 0, 0, 0, 0, 0, 0, 0};
      chi = (bf16x8){0, 0, 0, 0, 0, 0, 0, 0};
      if (y8 >= 0 && y8 < 2 * L) clo = *(const bf16x8*)(GR + y8);
      if (y8 + 8 >= 0 && y8 + 8 < 2 * L) chi = *(const bf16x8*)(GR + y8 + 8);
    }
  };
  auto st_chunk = [&](int buf) {
    if (tid < 66) {
#pragma unroll
      for (int r = 0; r < 8; ++r) {
        bf16x8 w;
#pragma unroll
        for (int e = 0; e < 8; ++e) w[e] = (r + e < 8) ? clo[(r + e) & 7] : chi[(r + e) & 7];
        *(bf16x8*)(sF + buf * 4224 + r * 528 + 8 * tid) = w;
      }
    }
  };
  gl_chunk(0);
  constexpr int NIT = NB * (L / 8) / 256;
  bf16x8 uv[NIT];
  u16 ul[NIT], ur[NIT];
#pragma unroll
  for (int q = 0; q < NIT; ++q) {
    const int it = q * 256 + tid;
    const int bi = it / (L / 8), s8 = (it % (L / 8)) * 8;
    if (order == 0) {
      const u16* src = HUT + ((size_t)bi * 768 + c) * L;
      uv[q] = *(const bf16x8*)(src + s8);
      ul[q] = s8 > 0 ? src[s8 - 1] : (u16)0;
      ur[q] = s8 + 8 < L ? src[s8 + 8] : (u16)0;
    } else {
      uv[q] = *(const bf16x8*)(Z1 + ((size_t)bi * 256 + c) * L + s8);
      ul[q] = 0; ur[q] = 0;
    }
  }
  __syncthreads();
  for (int i = tid; i < NB * RSTR / 8; i += 256) *(bf16x8*)(sU + i * 8) = (bf16x8){0, 0, 0, 0, 0, 0, 0, 0};
  __syncthreads();
  {
    const float w0 = p.in[IX_HSW][(l * 3 + 0) * 768 + c], w1 = p.in[IX_HSW][(l * 3 + 1) * 768 + c],
                w2 = p.in[IX_HSW][(l * 3 + 2) * 768 + c], bs = p.in[IX_HSB][l * 768 + c];
#pragma unroll
    for (int q = 0; q < NIT; ++q) {
      const int it = q * 256 + tid;
      const int bi = it / (L / 8), s8 = (it % (L / 8)) * 8;
      bf16x8 ov;
      if (order == 0) {
        float x[10];
        x[0] = bf2f(ul[q]);
        x[9] = bf2f(ur[q]);
#pragma unroll
        for (int e = 0; e < 8; ++e) x[1 + e] = bfs(uv[q][e]);
#pragma unroll
        for (int e = 0; e < 8; ++e) ov[e] = (short)f2bf(w0 * x[e] + w1 * x[e + 1] + w2 * x[e + 2] + bs);
      } else {
        ov = uv[q];
      }
      *(bf16x8*)(sU + ub(bi) + s8) = ov;
    }
  }
  f32x4 acc[NG];
#pragma unroll
  for (int g = 0; g < NG; ++g) acc[g] = (f32x4){0.f, 0.f, 0.f, 0.f};
  const int bil = CFG ? (fr & 7) : fr;
  const int hfl = CFG ? (fr >> 3) : 0;
  const int ubl = ub(bil) + 16 * hfl + 8 * fq;
  const int rr = (16 - fr) & 7;
  const int tw = T0 + wid * (NG * GSTEP);
  st_chunk(0);
  __syncthreads();
  if (CFG) {
    auto win = [&](int d) {
      int slo = tw + 32 * d;
      const bool valid = (slo >= -32 && slo <= L - 32);
      slo = valid ? slo : -64;
      return *(const bf16x8*)(sU + ubl + slo);
    };
    bf16x8 ring[8];
    const int i0 = T0 / 32 - 63;
#pragma unroll
    for (int g = 1; g < 8; ++g) ring[(g - 1) & 7] = win(g - i0);
#pragma unroll 1
    for (int ch = 0; ch < NCH; ++ch) {
      if (ch + 1 < NCH) gl_chunk(ch + 1);
      const int ic0 = i0 + 16 * ch;
      const u16* fb = sF + (ch & 1) * 4224 + rr * 528;
#pragma unroll
      for (int ii = 0; ii < 16; ++ii) {
        const int i = ic0 + ii;
        const int rel0 = 32 * (15 - ii) + 16 - fr + 8 * fq;
        const bf16x8 af = *(const bf16x8*)(fb + (rel0 - rr));
        ring[(7 - ii) & 7] = win(-i);
#pragma unroll
        for (int g = 0; g < 8; ++g) acc[g] = __builtin_amdgcn_mfma_f32_16x16x32_bf16(af, ring[(g + 15 - ii) & 7], acc[g], 0, 0, 0);
      }
      if (ch + 1 < NCH) st_chunk((ch + 1) & 1);
      __syncthreads();
    }
  } else {
#pragma unroll 1
  for (int ch = 0; ch < NCH; ++ch) {
    if (ch + 1 < NCH) { gl_chunk(ch + 1); st_chunk((ch + 1) & 1); }
    const int ic0 = (CFG ? (T0 / 32 - 63) : -7) + 16 * ch;
    const u16* fb = sF + (ch & 1) * 4224 + rr * 528;
#pragma unroll 2
    for (int ii = 0; ii < 16; ++ii) {
      const int i = ic0 + ii;
      const int rel0 = 32 * (15 - ii) + 16 - fr + 8 * fq;
      const bf16x8 af = *(const bf16x8*)(fb + (rel0 - rr));
      bf16x8 bv[NG];
#pragma unroll
      for (int g = 0; g < NG; ++g) {
        int slo = tw + g * GSTEP - 32 * i;
        const bool valid = CFG ? (slo >= -32 && slo <= L - 32) : (slo >= -16 && slo <= L - 16);
        slo = valid ? slo : -64;
        bv[g] = *(const bf16x8*)(sU + ubl + slo);
      }
#pragma unroll
      for (int g = 0; g < NG; ++g) acc[g] = __builtin_amdgcn_mfma_f32_16x16x32_bf16(af, bv[g], acc[g], 0, 0, 0);
    }
    __syncthreads();
  }
  }
  const int xc = 256 * (1 + order) + c;
  const float w0 = p.in[IX_HSW][(l * 3 + 0) * 768 + xc], w1 = p.in[IX_HSW][(l * 3 + 1) * 768 + xc],
              w2 = p.in[IX_HSW][(l * 3 + 2) * 768 + xc], bs = p.in[IX_HSB][l * 768 + xc];
  const float dsk = p.in[IX_HBIAS][(l * 2 + order) * 256 + c];
  const u16* xrow = HUT + ((size_t)bil * 768 + xc) * L;
  u16* cat = (u16*)(p.ws + WS_BIG + BG_CONCAT);
  bf16x4 xm[NG];
  u16 xl[NG], xr[NG];
#pragma unroll
  for (int g = 0; g < NG; ++g) {
    const int tb = tw + g * GSTEP + 16 * hfl + fq * 4;
    xm[g] = *(const bf16x4*)(xrow + tb);
    xl[g] = (tb > 0) ? xrow[tb - 1] : (u16)0;
    xr[g] = (tb + 4 < L) ? xrow[tb + 4] : (u16)0;
  }
#pragma unroll
  for (int g = 0; g < NG; ++g) {
    const int tb = tw + g * GSTEP + 16 * hfl + fq * 4;
    float x[6];
    x[0] = bf2f(xl[g]); x[5] = bf2f(xr[g]);
#pragma unroll
    for (int e = 0; e < 4; ++e) x[1 + e] = bfs(xm[g][e]);
    float z[4];
#pragma unroll
    for (int j = 0; j < 4; ++j) {
      float gate = w0 * x[j] + w1 * x[j + 1] + w2 * x[j + 2] + bs;
      float uin = bf2f(sU[ub(bil) + tb + j]);
      z[j] = gate * (acc[g][j] + dsk * uin);
    }
    if (order == 0) {
      *(bf16x4*)(Z1 + ((size_t)bil * 256 + c) * L + tb) = pack4(z[0], z[1], z[2], z[3]);
    } else {
      const int rb = row_base(CFG, bil) + tb;
#pragma unroll
      for (int j = 0; j < 4; ++j) cat[(size_t)(rb + j) * 1024 + 768 + c] = f2bf(z[j]);
    }
  }
}

constexpr int NPHASE = 18;

#define JOBLOOP(START, COUNT, ...)                                    \
  {                                                                   \
    int _f = (int)blockIdx.x - (int)((START) % G);                    \
    if (_f < 0) _f += G;                                              \
    for (int job = _f; job < (COUNT); job += G) { __VA_ARGS__; }      \
  }
#define PJOBLOOP(ID, START, COUNT, ...) { JOBLOOP(START, COUNT, __VA_ARGS__) if (PROBE_SUB == ID) { __syncthreads(); JOBLOOP(START, COUNT, __VA_ARGS__) } }

template <int S>
DEVI void stage_loop(const Params& p, int l, char* smem) {
  char* ws = p.ws;
  const int G = gridDim.x;
  const u16* HB = (const u16*)(ws + WS_HB);
  if (S == 0) {
    PJOBLOOP(9, 0, 384, mod_job(p, job, smem));
    PJOBLOOP(10, 384, 288, hymlp_job(p, job, smem));
    JOBLOOP(672, NCONV_A, conv_group_a(p, 0, job, smem));
    JOBLOOP(672 + NCONV_A, NCONV_B, conv_group_b(p, 0, job, smem));
    JOBLOOP(672 + NCONV_A + NCONV_B, 2304, table_job(p, job));
    JOBLOOP(2976 + NCONV_A + NCONV_B, 256, cc_job(p, job));
  } else if (S == 1) {
    JOBLOOP(0, 288, hyfin_job(p, job, smem));
    JOBLOOP(288, 2560, rowop_job(p, 0, 0, job));
  } else if (S == 2) {
    PJOBLOOP(11, 0, 1760, gemm_job<EPI_WIN, 8>(p, l, HB, 1024, (const u16*)(ws + WS_WIN), 1024, 1024, job % 80, job / 80, 0, smem));
    JOBLOOP(1760, 32, l1extra_job(p, l, job));
  } else if (S == 3) {
    PJOBLOOP(5, 0, 512, hyena_job<1>(p, l, 0, job, smem));
    PJOBLOOP(6, 512, 256, gemm_job<EPI_FOUR, 4>(p, l, (const u16*)(ws + WS_TABL), 4096,
                                         (const u16*)(ws + WS_BIG + BG_XCS) + (size_t)MC * 512 + (size_t)(job >> 5) * 256 * 4096,
                                         4096, 4096, (job >> 1) & 15, job & 1, MC + (job >> 5) * 2048, smem));
    PJOBLOOP(7, 768, 480, gemm_job<EPI_MQ, 4>(p, l, (const u16*)(ws + WS_BIG + BG_CQ), 256, (const u16*)(ws + WS_WUQ), 256, 256, job % 160, job / 160, 0, smem));
    PJOBLOOP(8, 1248, 320, gemm_job<EPI_MKV, 8>(p, l, (const u16*)(ws + WS_BIG + BG_CKV), 128, (const u16*)(ws + WS_WUKV), 128, 128, job % 80, job / 80, 0, smem));
    JOBLOOP(1568, 64, gemm_job<EPI_MKVC, 4>(p, l, (const u16*)(ws + WS_CC) + (size_t)l * 2048 * 128, 128, (const u16*)(ws + WS_WUKVP), 128, 128, job & 15, job >> 4, 0, smem));
    JOBLOOP(1632, 64, gemm_job<EPI_FOUR, 4>(p, l, (const u16*)(ws + WS_TABC), 512, (const u16*)(ws + WS_BIG + BG_XCS) + (size_t)(job >> 2) * 256 * 512,
                                         512, 512, (job >> 1) & 1, job & 1, (job >> 2) * 256, smem));
    JOBLOOP(1696, 256, hyena_job<0>(p, l, 0, job, smem));
  } else if (S == 4) {
    PJOBLOOP(0, 0, 128, state_job(p, l, job, smem));
    PJOBLOOP(1, 128, 640, attn_job<0>(p, l, job, smem));
    PJOBLOOP(2, 768, 640, attn_job<1>(p, l, job, smem));
    PJOBLOOP(3, 1408, 512, hyena_job<1>(p, l, 1, job, smem));
    PJOBLOOP(4, 1920, 256, hyena_job<0>(p, l, 1, job, smem));
  } else if (S == 5) {
    PJOBLOOP(12, 0, 640, gemm_job<EPI_WOUT, 8>(p, l, (const u16*)(ws + WS_BIG + BG_CONCAT), 1024, (const u16*)(ws + WS_WOUT), 1024, 1024, (job & 7) + 8 * (job >> 6), (job >> 3) & 7, 0, smem));
  } else if (S == 6) {
    const int nc = (l == 0) ? NCONV_A : 0;
    JOBLOOP(0, nc, conv_group_a(p, 1, job, smem));
    JOBLOOP(nc, 2560, rowop_job(p, l, 1, job));
  } else if (S == 7) {
    PJOBLOOP(13, 0, 3520, gemm_job<EPI_FFNUP, 8>(p, l, HB, 1024, (const u16*)(ws + WS_WGU), 1024, 1024, job % 80, job / 80, 0, smem));
  } else if (S == 8) {
    PJOBLOOP(14, 0, 640, gemm_job<EPI_FFNDN, 8>(p, l, (const u16*)(ws + WS_BIG + BG_ACT), 2816, (const u16*)(ws + WS_WD), 2816, 2816, (job & 7) + 8 * (job >> 6), (job >> 3) & 7, 0, smem));
  } else {
    const int nc = (l == 0) ? NCONV_B : 0;
    JOBLOOP(0, nc, conv_group_b(p, 1, job, smem));
    JOBLOOP(nc, 2560, rowop_job(p, l, 2, job));
  }
}

#if !SINGLE_LAUNCH
template <int S>
__global__ void __launch_bounds__(256, 2) stage_kernel(Params p, int l) {
  __shared__ __attribute__((aligned(16))) char smem[SMEM_BYTES];
  stage_loop<S>(p, l, smem);
}

#else
__global__ void __launch_bounds__(256, 2) mega(Params p) {
  __shared__ __attribute__((aligned(16))) char smem[SMEM_BYTES];
  cg::grid_group grid = cg::this_grid();
  if (p.out == nullptr) grid.sync();
  volatile LAS unsigned* xbw = (volatile LAS unsigned*)(smem + SMEM_BYTES - 16);
  if (threadIdx.x == 0) { xbw[0] = 0u; xbw[1] = 0u; }
  __syncthreads();
  XcdBarrier xb = xcd_barrier_post((unsigned*)(p.ws + WS_BAR), xbw);
  for (int i = 0; i < PROBE_SYNCS; ++i) xcd_barrier(xb);
#define RUNSTG(S, L) { stage_loop<S>(p, L, smem); if (PROBE_ST == S && (S != 6 || L == 0)) { xcd_barrier(xb); stage_loop<S>(p, L, smem); } }
  RUNSTG(0, 0); xcd_barrier(xb);
  RUNSTG(1, 0); xcd_barrier(xb);
  for (int l = 0; l < 2; ++l) {
    RUNSTG(2, l); xcd_barrier(xb);
    RUNSTG(3, l); xcd_barrier(xb);
    RUNSTG(4, l); xcd_barrier(xb);
    RUNSTG(5, l); xcd_barrier(xb);
    RUNSTG(6, l); xcd_barrier(xb);
    RUNSTG(7, l); xcd_barrier(xb);
    RUNSTG(8, l); xcd_barrier(xb);
    stage_loop<9>(p, l, smem);
    if (l == 0) xcd_barrier(xb);
  }
}

#endif

extern "C" void kernel_launch(void* const* d_in, const int* in_sizes, int n_in, void* d_out, int out_size, void* d_ws,
                              size_t ws_size, hipStream_t stream) {
  Params p{};
  for (int i = 0; i < N_IN; ++i) p.in[i] = (const float*)d_in[i];
  p.out = (float*)d_out;
  p.ws = (char*)d_ws;
  if (ws_size < WS_TOTAL) fprintf(stderr, "workspace too small: %zu < %zu\n", ws_size, (size_t)WS_TOTAL);
  static int grid_blocks = 0;
  if (!grid_blocks) {
    int dev = 0, cus = 0, per_cu = 0;
    (void)hipGetDevice(&dev);
    (void)hipDeviceGetAttribute(&cus, hipDeviceAttributeMultiprocessorCount, dev);
#if SINGLE_LAUNCH
    (void)hipOccupancyMaxActiveBlocksPerMultiprocessor(&per_cu, mega, 256, 0);
#else
    per_cu = 2;
#endif
    if (per_cu < 1) per_cu = 1;
    if (per_cu > 2) per_cu = 2;
    grid_blocks = cus * per_cu;
  }
#if SINGLE_LAUNCH
  (void)hipMemsetAsync(p.ws + WS_BAR, 0, XCD_BAR_WORDS * 4, stream);
  void* args[] = {&p};
  hipError_t e = hipLaunchCooperativeKernel((void*)mega, dim3(grid_blocks), dim3(256), args, 0, stream);
  if (e != hipSuccess) fprintf(stderr, "cooperative launch failed: %s (grid %d)\n", hipGetErrorString(e), grid_blocks);
#else
  const dim3 g(grid_blocks), t(256);
#define RUNST(S, L) for (int r_ = 0; r_ < ((PROBE_STAGE == S) ? 2 : 1); ++r_) stage_kernel<S><<<g, t, 0, stream>>>(p, L)
  RUNST(0, 0);
  RUNST(1, 0);
  for (int l = 0; l < 2; ++l) {
    RUNST(2, l);
    RUNST(3, l);
    RUNST(4, l);
    RUNST(5, l);
    RUNST(6, l);
    RUNST(7, l);
    RUNST(8, l);
    RUNST(9, l);
  }
#endif
}
```
